# Optimizing an MI355X kernel written in HIP

```python
import jax
import jax.numpy as jnp
from jax import lax
import numpy as np

D_MODEL = 1024
BATCH = 4
SEQ = 4096
DEPTH = 4

GRID_W = 64
CTX_LEN = 256
N_MIXERS = 4
MIX_RET, MIX_NAT, MIX_POOL, MIX_SWA = 0, 1, 2, 3
N_RET = len(range(MIX_RET, DEPTH, N_MIXERS))
N_NAT = len(range(MIX_NAT, DEPTH, N_MIXERS))
N_POOL = len(range(MIX_POOL, DEPTH, N_MIXERS))
N_SWA = len(range(MIX_SWA, DEPTH, N_MIXERS))
EPS = 1e-6
NEG_INF = -1e30
ROPE_BASE = 10000.0
FFN_HIDDEN = 2816
RET_HEADS = 4
RET_QK_DIM = D_MODEL // RET_HEADS
RET_V_DIM = 2 * RET_QK_DIM
RET_CHUNK = 128
NAT_HEADS = 16
NAT_HEAD_DIM = D_MODEL // NAT_HEADS
NAT_KH = 8
NAT_KW = 16
POOL_WINDOWS = (2, 4, 8, 16)
POOL_GROUPS = len(POOL_WINDOWS)
POOL_GROUP_DIM = D_MODEL // POOL_GROUPS
SWA_Q_HEADS = 16
SWA_KV_HEADS = 4
SWA_HEAD_DIM = D_MODEL // SWA_Q_HEADS
SWA_WINDOW = 128
SWA_BLOCK = 128

kernel_name = 'hybrid_interleaved_diffusion_trunk'


def rms_norm(x, g):
    xf = x.astype(jnp.float32)
    y = xf * lax.rsqrt(jnp.mean(xf * xf, axis=-1, keepdims=True) + EPS)
    return (y * g.astype(jnp.float32)).astype(x.dtype)


def ada_in(h, g, m, j):
    xn = rms_norm(h, g)
    return (xn * (1.0 + m[:, j, 1][:, None]) + m[:, j, 0][:, None]).astype(h.dtype)


def gated_residual(h, m, j, y, w):
    return h + (w * m[:, j, 2][:, None] * y).astype(h.dtype)


def swiglu(x, w_in, w_out):
    a, b = jnp.split(x @ w_in, 2, axis=-1)
    return (jax.nn.silu(a) * b) @ w_out


def rope_angles(positions, dim):
    seg = dim // len(positions)
    inv = ROPE_BASE ** (-jnp.arange(0, seg, 2, dtype=jnp.float32) / seg)
    return jnp.concatenate([jnp.tile(p.astype(jnp.float32)[:, None] * inv, (1, 2)) for p in positions], axis=-1)


def apply_rope(x, ang, n_axes):
    xf = x.astype(jnp.float32)
    segs = jnp.split(xf, 2 * n_axes, axis=-1)
    rot = jnp.concatenate([s for a in range(n_axes) for s in (-segs[2 * a + 1], segs[2 * a])], axis=-1)
    return (xf * jnp.cos(ang)[None, :, None] + rot * jnp.sin(ang)[None, :, None]).astype(x.dtype)


def retention_scan(q, k, v, log_gamma, s0, include_diag):
    B, T, H, _ = q.shape
    dv = v.shape[-1]
    C = RET_CHUNK
    N = T // C
    idx = jnp.arange(C, dtype=jnp.float32)
    diff = idx[:, None] - idx[None, :]
    keep = (diff >= 0) if include_diag else (diff > 0)
    intra = jnp.where(keep[None], jnp.exp(jnp.maximum(diff, 0.0)[None] * log_gamma[:, None, None]), 0.0)
    q_dec = jnp.exp((idx + 1.0)[None] * log_gamma[:, None])
    k_dec = jnp.exp((C - 1.0 - idx)[None] * log_gamma[:, None])
    c_dec = jnp.exp(C * log_gamma)[:, None, None]

    def chunks(a):
        return a.reshape(B, N, C, H, a.shape[-1]).transpose(1, 0, 3, 2, 4)

    def step(s, qkv):
        qn, kn, vn = qkv
        att = jnp.einsum('bhid,bhjd->bhij', qn, kn) * intra
        o = jnp.einsum('bhij,bhjv->bhiv', att, vn) + jnp.einsum('bhid,bhdv->bhiv', qn * q_dec[..., None], s)
        s = s * c_dec + jnp.einsum('bhjd,bhjv->bhdv', kn * k_dec[..., None], vn)
        return s, o

    s_fin, o = lax.scan(step, s0, (chunks(q), chunks(k), chunks(v)))
    return o.transpose(1, 0, 3, 2, 4).reshape(B, T, H, dv), s_fin


def retention_bidir(q, k, v, lg_f, lg_b, s0_f, s0_b):
    o_f, s_f = retention_scan(q, k, v, lg_f, s0_f, True)
    rev = lambda a: jnp.flip(a, axis=1)
    o_b, s_b = retention_scan(rev(q), rev(k), rev(v), lg_b, s0_b, False)
    return o_f + rev(o_b), s_f, s_b


def retention_mixer(xl, xc, w_in, w_out, gn_g, decay_f, decay_b, ctx_out):
    H, DK, DV = RET_HEADS, RET_QK_DIM, RET_V_DIM
    lg_f = jax.nn.log_sigmoid(decay_f.astype(jnp.float32))
    lg_b = jax.nn.log_sigmoid(decay_b.astype(jnp.float32))

    def project(x, ang):
        B, T, _ = x.shape
        q, k, v, g = jnp.split(x @ w_in, [H * DK, 2 * H * DK, 2 * H * DK + H * DV], axis=-1)
        q = q.reshape(B, T, H, DK)
        k = k.reshape(B, T, H, DK) * DK ** -0.5
        v = v.reshape(B, T, H, DV)
        if ang is not None:
            q = apply_rope(q, ang, 1)
            k = apply_rope(k, ang, 1)
        return q.astype(jnp.float32), k.astype(jnp.float32), v.astype(jnp.float32), g

    def read_out(o, g):
        mu = jnp.mean(o, axis=-1, keepdims=True)
        var = jnp.mean(jnp.square(o - mu), axis=-1, keepdims=True)
        on = (o - mu) * lax.rsqrt(var + EPS) * gn_g.astype(jnp.float32).reshape(H, DV)
        B, T = o.shape[:2]
        return (jax.nn.silu(g) * on.reshape(B, T, H * DV).astype(g.dtype)) @ w_out

    qc, kc, vc, gc = project(xc, None)
    Bc, L = xc.shape[:2]
    if ctx_out:
        zeros = jnp.zeros((Bc, H, DK, DV), jnp.float32)
        oc, s_f, s_b = retention_bidir(qc, kc, vc, lg_f, lg_b, zeros, zeros)
        yc = read_out(oc, gc)
    else:
        pos = jnp.arange(L, dtype=jnp.float32)[:, None]
        s_f = jnp.einsum('bthd,bthv->bhdv', kc * jnp.exp((L - 1.0 - pos) * lg_f)[None, :, :, None], vc)
        s_b = jnp.einsum('bthd,bthv->bhdv', kc * jnp.exp(pos * lg_b)[None, :, :, None], vc)
        yc = None
    T = xl.shape[1]
    ang = rope_angles([jnp.arange(T)], DK)
    ql, kl, vl, gl = project(xl, ang)
    ol, _, _ = retention_bidir(ql, kl, vl, lg_f, lg_b, s_f, s_b)
    return read_out(ol, gl), yc


def nat_mixer(xl, xc, w_qkv, w_o, rpb, ctx_out):
    H, DH = NAT_HEADS, NAT_HEAD_DIM

    def project(x):
        B, T, _ = x.shape
        q, k, v = jnp.split(x @ w_qkv, 3, axis=-1)
        return (q * DH ** -0.5).reshape(B, T, H, DH), k.reshape(B, T, H, DH), v.reshape(B, T, H, DH)

    qc, kc, vc = project(xc)
    ql, kl, vl = project(xl)
    B, T, _ = xl.shape
    rows = T // GRID_W
    kh = min(NAT_KH, rows)
    nk = kh * NAT_KW
    qg = ql.reshape(B, rows, GRID_W, H, DH)
    kg = kl.reshape(B, rows, GRID_W, H, DH)
    vg = vl.reshape(B, rows, GRID_W, H, DH)
    cols = jnp.arange(GRID_W)
    col_idx = jnp.clip(cols - NAT_KW // 2, 0, GRID_W - NAT_KW)[:, None] + jnp.arange(NAT_KW)
    col_bias_idx = col_idx - cols[:, None] + NAT_KW - 1

    def row_block(r):
        r0 = jnp.clip(r - kh // 2, 0, rows - kh)
        kw = lax.dynamic_slice_in_dim(kg, r0, kh, axis=1)[:, :, col_idx]
        vw = lax.dynamic_slice_in_dim(vg, r0, kh, axis=1)[:, :, col_idx]
        qr = lax.dynamic_index_in_dim(qg, r, axis=1, keepdims=False)
        row_bias_idx = r0 + jnp.arange(kh) - r + NAT_KH - 1
        bias = rpb[:, row_bias_idx][:, :, col_bias_idx].transpose(0, 2, 1, 3)
        s_nb = jnp.einsum('bchd,bacnhd->bhcan', qr, kw).astype(jnp.float32) + bias.astype(jnp.float32)
        s_cx = jnp.einsum('bchd,bjhd->bhcj', qr, kc).astype(jnp.float32)
        p = jax.nn.softmax(jnp.concatenate([s_nb.reshape(B, H, GRID_W, nk), s_cx], axis=-1), axis=-1).astype(vl.dtype)
        p_nb = p[..., :nk].reshape(B, H, GRID_W, kh, NAT_KW)
        return jnp.einsum('bhcan,bacnhd->bchd', p_nb, vw) + jnp.einsum('bhcj,bjhd->bchd', p[..., nk:], vc)

    o = lax.map(row_block, jnp.arange(rows))
    yl = o.transpose(1, 0, 2, 3, 4).reshape(B, T, H * DH) @ w_o
    yc = None
    if ctx_out:
        p = jax.nn.softmax(jnp.einsum('bihd,bjhd->bhij', qc, kc).astype(jnp.float32), axis=-1).astype(vc.dtype)
        oc = jnp.einsum('bhij,bjhd->bihd', p, vc)
        yc = oc.reshape(oc.shape[0], oc.shape[1], H * DH) @ w_o
    return yl, yc


def pool_mixer(x, w_grp, scale):
    B, T, D = x.shape
    G, Dg = POOL_GROUPS, POOL_GROUP_DIM
    xf = x.astype(jnp.float32).reshape(B, T, G, Dg)
    csum = jnp.concatenate([jnp.zeros((B, 1, G, Dg), jnp.float32), jnp.cumsum(xf, axis=1)], axis=1)
    half = jnp.asarray([w // 2 for w in POOL_WINDOWS])
    t = jnp.arange(T)[:, None]
    lo = jnp.clip(t - half, 0, T)
    hi = jnp.clip(t + half, 0, T)
    grp = jnp.arange(G)[None, :]
    mean = (csum[:, hi, grp] - csum[:, lo, grp]) / (hi - lo).astype(jnp.float32)[None, :, :, None]
    pooled = (mean - xf).astype(x.dtype)
    return jnp.einsum('btgc,gcd->btgd', pooled, w_grp).reshape(B, T, D) * scale


def swa_mixer(xl, xc, w_qkv, w_o, sink, ctx_out):
    HQ, HKV, DH = SWA_Q_HEADS, SWA_KV_HEADS, SWA_HEAD_DIM
    G = HQ // HKV

    def project(x, ang):
        B, T, _ = x.shape
        q, k, v = jnp.split(x @ w_qkv, [HQ * DH, (HQ + HKV) * DH], axis=-1)
        q = q.reshape(B, T, HQ, DH)
        k = k.reshape(B, T, HKV, DH)
        v = v.reshape(B, T, HKV, DH)
        if ang is not None:
            q = apply_rope(q, ang, 2)
            k = apply_rope(k, ang, 2)
        return (q * DH ** -0.5).reshape(B, T, HKV, G, DH), k, v

    B, T, _ = xl.shape
    t = jnp.arange(T)
    ang = rope_angles([t // GRID_W, t % GRID_W], DH)
    ql, kl, vl = project(xl, ang)
    qc, kc, vc = project(xc, None)
    sink_l = sink.astype(jnp.float32).reshape(HKV, G)
    nb = T // SWA_BLOCK
    nw = SWA_WINDOW // SWA_BLOCK
    nk = (2 * nw + 1) * SWA_BLOCK

    def band(a):
        ap = jnp.pad(a, ((0, 0), (SWA_WINDOW, SWA_WINDOW), (0, 0), (0, 0))).reshape(B, nb + 2 * nw, SWA_BLOCK, HKV, DH)
        return jnp.concatenate([ap[:, o:o + nb] for o in range(2 * nw + 1)], axis=2)

    kb, vb = band(kl), band(vl)
    qb = ql.reshape(B, nb, SWA_BLOCK, HKV, G, DH)
    qpos = (jnp.arange(nb)[:, None] * SWA_BLOCK + jnp.arange(SWA_BLOCK))[:, :, None]
    kpos = (jnp.arange(nb)[:, None] * SWA_BLOCK - SWA_WINDOW + jnp.arange(nk))[:, None, :]
    allowed = (jnp.abs(qpos - kpos) <= SWA_WINDOW) & (kpos >= 0) & (kpos < T)
    s_loc = jnp.where(allowed, jnp.einsum('bnikgd,bnjkd->bkgnij', qb, kb).astype(jnp.float32), NEG_INF)
    s_cx = jnp.einsum('bnikgd,bjkd->bkgnij', qb, kc).astype(jnp.float32)
    s_sk = jnp.broadcast_to(sink_l[None, :, :, None, None, None], s_loc.shape[:-1] + (1,))
    p = jax.nn.softmax(jnp.concatenate([s_loc, s_cx, s_sk], axis=-1), axis=-1)[..., :-1].astype(vl.dtype)
    o = jnp.einsum('bkgnij,bnjkd->bnikgd', p[..., :nk], vb) + jnp.einsum('bkgnij,bjkd->bnikgd', p[..., nk:], vc)
    yl = o.reshape(B, T, HQ * DH) @ w_o
    yc = None
    if ctx_out:
        s = jnp.einsum('bikgd,bjkd->bkgij', qc, kc).astype(jnp.float32)
        sk = jnp.broadcast_to(sink_l[None, :, :, None, None], s.shape[:-1] + (1,))
        pc = jax.nn.softmax(jnp.concatenate([s, sk], axis=-1), axis=-1)[..., :-1].astype(vc.dtype)
        oc = jnp.einsum('bkgij,bjkd->bikgd', pc, vc)
        yc = oc.reshape(oc.shape[0], oc.shape[1], HQ * DH) @ w_o
    return yl, yc


def setup_inputs(seed: int = 0) -> dict:
    key = jax.random.key(seed)
    ks = jax.random.split(key, 24)
    D, F = D_MODEL, FFN_HIDDEN
    nrm = lambda k, shape, s: jax.random.normal(k, shape, jnp.float32) * s
    ret_in = 2 * RET_HEADS * RET_QK_DIM + 2 * RET_HEADS * RET_V_DIM
    ret_v = RET_HEADS * RET_V_DIM
    decay_logit = jnp.log(2.0 ** (5.0 + jnp.arange(RET_HEADS, dtype=jnp.float32)) - 1.0)
    nat_w = NAT_HEADS * NAT_HEAD_DIM
    swa_in = (SWA_Q_HEADS + 2 * SWA_KV_HEADS) * SWA_HEAD_DIM
    swa_o = SWA_Q_HEADS * SWA_HEAD_DIM
    return {
        'x': nrm(ks[0], (BATCH, SEQ, D), 1.0),
        'c': nrm(ks[1], (BATCH, D), 1.0),
        'ctx': nrm(ks[2], (BATCH, CTX_LEN, D), 1.0),
        'c_ctx': nrm(ks[3], (D,), 1.0),
        'w_mod': nrm(ks[4], (DEPTH, D, 9 * D), 0.5 * D ** -0.5),
        'b_mod': nrm(ks[5], (DEPTH, 9 * D), 0.01),
        'norm_g': 1.0 + nrm(ks[6], (DEPTH, 3, D), 0.02),
        'ffn_w_in': nrm(ks[7], (DEPTH, 2, D, 2 * F), D ** -0.5),
        'ffn_w_out': nrm(ks[8], (DEPTH, 2, F, D), F ** -0.5),
        'ret_w_in': nrm(ks[9], (N_RET, D, ret_in), D ** -0.5),
        'ret_w_out': nrm(ks[10], (N_RET, ret_v, D), ret_v ** -0.5),
        'ret_gn_g': 1.0 + nrm(ks[11], (N_RET, ret_v), 0.02),
        'ret_decay_f': decay_logit + nrm(ks[12], (N_RET, RET_HEADS), 0.05),
        'ret_decay_b': decay_logit + nrm(ks[13], (N_RET, RET_HEADS), 0.05),
        'nat_w_qkv': nrm(ks[14], (N_NAT, D, 3 * nat_w), D ** -0.5),
        'nat_w_o': nrm(ks[15], (N_NAT, nat_w, D), nat_w ** -0.5),
        'nat_rpb': nrm(ks[16], (N_NAT, NAT_HEADS, 2 * NAT_KH - 1, 2 * NAT_KW - 1), 0.1),
        'pool_w': nrm(ks[17], (N_POOL, POOL_GROUPS, POOL_GROUP_DIM, POOL_GROUP_DIM), POOL_GROUP_DIM ** -0.5),
        'pool_scale': 1.0 + nrm(ks[18], (N_POOL, D), 0.02),
        'swa_w_qkv': nrm(ks[19], (N_SWA, D, swa_in), D ** -0.5),
        'swa_w_o': nrm(ks[20], (N_SWA, swa_o, D), swa_o ** -0.5),
        'swa_sink': nrm(ks[21], (N_SWA, SWA_Q_HEADS), 0.5),
        'final_norm_g': 1.0 + nrm(ks[22], (D,), 0.02),
    }


def reference(x, c, ctx, c_ctx, w_mod, b_mod, norm_g, ffn_w_in, ffn_w_out,
              ret_w_in, ret_w_out, ret_gn_g, ret_decay_f, ret_decay_b,
              nat_w_qkv, nat_w_o, nat_rpb, pool_w, pool_scale,
              swa_w_qkv, swa_w_o, swa_sink, final_norm_g):
    D = x.shape[-1]
    h, hc = x, ctx
    s_c = jax.nn.silu(c)
    s_cc = jax.nn.silu(c_ctx)[None]
    for i in range(DEPTH):
        kind, occ = i % N_MIXERS, i // N_MIXERS
        last = i == DEPTH - 1
        ctx_live = (not last) or kind != MIX_POOL
        ml = (s_c @ w_mod[i] + b_mod[i]).reshape(-1, 3, 3, D)
        h = gated_residual(h, ml, 0, swiglu(ada_in(h, norm_g[i, 0], ml, 0), ffn_w_in[i, 0], ffn_w_out[i, 0]), 0.5)
        xl = ada_in(h, norm_g[i, 1], ml, 1)
        xc = None
        if ctx_live:
            mc = (s_cc @ w_mod[i] + b_mod[i]).reshape(-1, 3, 3, D)
            hc = gated_residual(hc, mc, 0, swiglu(ada_in(hc, norm_g[i, 0], mc, 0), ffn_w_in[i, 0], ffn_w_out[i, 0]), 0.5)
            xc = ada_in(hc, norm_g[i, 1], mc, 1)
        if kind == MIX_RET:
            yl, yc = retention_mixer(xl, xc, ret_w_in[occ], ret_w_out[occ], ret_gn_g[occ],
                                     ret_decay_f[occ], ret_decay_b[occ], not last)
        elif kind == MIX_NAT:
            yl, yc = nat_mixer(xl, xc, nat_w_qkv[occ], nat_w_o[occ], nat_rpb[occ], not last)
        elif kind == MIX_POOL:
            yl = pool_mixer(xl, pool_w[occ], pool_scale[occ])
            yc = None if last else pool_mixer(xc, pool_w[occ], pool_scale[occ])
        else:
            yl, yc = swa_mixer(xl, xc, swa_w_qkv[occ], swa_w_o[occ], swa_sink[occ], not last)
        h = gated_residual(h, ml, 1, yl, 1.0)
        if not last:
            hc = gated_residual(hc, mc, 1, yc, 1.0)
            hc = gated_residual(hc, mc, 2, swiglu(ada_in(hc, norm_g[i, 2], mc, 2), ffn_w_in[i, 1], ffn_w_out[i, 1]), 0.5)
        h = gated_residual(h, ml, 2, swiglu(ada_in(h, norm_g[i, 2], ml, 2), ffn_w_in[i, 1], ffn_w_out[i, 1]), 0.5)
    return rms_norm(h, final_norm_g)
```

```cpp
#include <hip/hip_runtime.h>
#include <hip/hip_cooperative_groups.h>
#include <cstdio>
#include <cstdint>
namespace cg = cooperative_groups;

#ifndef MK_MASK
#define MK_MASK 0xFFFF
#endif
#ifndef MK_DUP
#define MK_DUP 0
#endif
#ifndef MK_MULTI
#define MK_MULTI 0
#endif

#define LAS __attribute__((address_space(3)))
typedef unsigned short bf16_t;
typedef short bf16x8 __attribute__((ext_vector_type(8)));
typedef short s16x4 __attribute__((ext_vector_type(4)));
typedef float f32x4 __attribute__((ext_vector_type(4)));
typedef float f32x2 __attribute__((ext_vector_type(2)));
typedef unsigned u32x4 __attribute__((ext_vector_type(4)));
typedef unsigned u32x2 __attribute__((ext_vector_type(2)));
#define DI __device__ __forceinline__

constexpr int D = 1024, NB = 4, SEQ = 4096, CTXL = 256, FF = 2816;
constexpr int ML = NB * SEQ;
constexpr int MC = NB * CTXL;
constexpr int MT = ML + MC;
constexpr int MODW = 9 * D;
constexpr float LOG2E = 1.4426950408889634f;
constexpr int NTHREADS = 512, NWAVES = 8;
constexpr int LDS_PHASE_BYTES = 147456, LDS_BYTES = LDS_PHASE_BYTES + 64;

constexpr size_t al256(size_t x) { return (x + 255) & ~(size_t)255; }
constexpr size_t OFF_MOD = 0;
constexpr size_t OFF_PTAB = al256(OFF_MOD + (size_t)4 * 5 * MODW * 4);
constexpr size_t OFF_BAR = al256(OFF_PTAB + 256);
constexpr size_t OFF_DEC = al256(OFF_BAR + 16384);
constexpr size_t OFF_CS2 = al256(OFF_DEC + 64);
constexpr size_t OFF_CS = al256(OFF_CS2 + 64 * 16 * 8);
constexpr size_t OFF_CST = al256(OFF_CS + (size_t)4096 * 128 * 8);
constexpr size_t OFF_WFI = al256(OFF_CST + (size_t)4096 * 128 * 8);
constexpr size_t OFF_WFO = al256(OFF_WFI + (size_t)8 * 5632 * 1024 * 2);
constexpr size_t OFF_WRI = al256(OFF_WFO + (size_t)8 * 1024 * 2816 * 2);
constexpr size_t OFF_WRO = al256(OFF_WRI + (size_t)6144 * 1024 * 2);
constexpr size_t OFF_WNQ = al256(OFF_WRO + (size_t)1024 * 2048 * 2);
constexpr size_t OFF_WNO = al256(OFF_WNQ + (size_t)3072 * 1024 * 2);
constexpr size_t OFF_WPL = al256(OFF_WNO + (size_t)1024 * 1024 * 2);
constexpr size_t OFF_WSQ = al256(OFF_WPL + (size_t)4 * 256 * 256 * 2);
constexpr size_t OFF_WSO = al256(OFF_WSQ + (size_t)1536 * 1024 * 2);
constexpr size_t OFF_H = al256(OFF_WSO + (size_t)1024 * 1024 * 2);
constexpr size_t OFF_XN = al256(OFF_H + (size_t)MT * 1024 * 4);
constexpr size_t OFF_ACT = al256(OFF_XN + (size_t)MT * 1024 * 2);
constexpr size_t ACT_BYTES = (size_t)2 * MT * 2048 * 2;
constexpr size_t OFF_MIX = al256(OFF_ACT + ACT_BYTES);
constexpr size_t OFF_RG = OFF_MIX;
constexpr size_t OFF_RQ = OFF_RG + (size_t)MT * 2048 * 2;
constexpr size_t OFF_RK = OFF_RQ + (size_t)MT * 1024 * 2;
constexpr size_t OFF_RKTF = OFF_RK + (size_t)MT * 1024 * 2;
constexpr size_t OFF_RKTB = OFF_RKTF + (size_t)MT * 1024 * 2;
constexpr size_t OFF_RVT = OFF_RKTB + (size_t)MT * 1024 * 2;
constexpr size_t WS_END = OFF_RVT + (size_t)MT * 2048 * 2;
constexpr size_t OFF_AQK = OFF_MIX;
constexpr size_t OFF_AVT = OFF_AQK + (size_t)MT * 2048 * 2;
constexpr size_t OFF_AO = OFF_AVT + (size_t)MT * 1024 * 2;
constexpr size_t OFF_PL = OFF_MIX;

DI unsigned f2bf(float f) { unsigned u = __builtin_bit_cast(unsigned, f); return (u + 0x7fffu + ((u >> 16) & 1u)) >> 16; }
typedef __bf16 hbf16x2 __attribute__((ext_vector_type(2)));
DI unsigned pk2(float lo, float hi) { const f32x2 v = {lo, hi}; const hbf16x2 b = __builtin_convertvector(v, hbf16x2); return __builtin_bit_cast(unsigned, b); }
DI float bflo(unsigned u) { return __builtin_bit_cast(float, u << 16); }
DI float bfhi(unsigned u) { return __builtin_bit_cast(float, u & 0xffff0000u); }
DI float silu_f(float a) { return a * __builtin_amdgcn_rcpf(1.f + __builtin_amdgcn_exp2f(-a * LOG2E)); }
#define LDS_BARRIER() do { asm volatile("s_waitcnt lgkmcnt(0)" ::: "memory"); __builtin_amdgcn_s_barrier(); } while (0)
DI int tid_opaque() { int t = threadIdx.x; asm volatile("" : "+v"(t)); return t; }
DI float shx(float v, int m, int lane) { return __builtin_bit_cast(float, __builtin_amdgcn_ds_bpermute((lane ^ m) << 2, __builtin_bit_cast(int, v))); }
DI float dpp_f(float v, const int ctrl_sel) {
    const int x = __builtin_bit_cast(int, v); int r;
    if (ctrl_sel == 0) r = __builtin_amdgcn_update_dpp(x, x, 0xB1, 0xF, 0xF, false);
    else if (ctrl_sel == 1) r = __builtin_amdgcn_update_dpp(x, x, 0x4E, 0xF, 0xF, false);
    else if (ctrl_sel == 2) r = __builtin_amdgcn_update_dpp(x, x, 0x124, 0xF, 0xF, false);
    else r = __builtin_amdgcn_update_dpp(x, x, 0x128, 0xF, 0xF, false);
    return __builtin_bit_cast(float, r);
}
DI float row16_sum(float v) { v += dpp_f(v, 0); v += dpp_f(v, 1); v += dpp_f(v, 2); v += dpp_f(v, 3); return v; }
DI float wave_sum(float v, int lane) {
    v = row16_sum(v);
    v += shx(v, 16, lane); v += shx(v, 32, lane);
    return v;
}
#define MFMA16(a, b, c) __builtin_amdgcn_mfma_f32_16x16x32_bf16((a), (b), (c), 0, 0, 0)

namespace pg8 {
constexpr int BM = 256, BK = 64, HALF = 128, HTB = HALF * BK * 2, STAGE_BYTES = 8 * HTB, NXCD = 8, WGM = 8;
DI int lds_byte(int r, int c) { const int st = (r >> 4) * 2 + (c >> 5), rr = r & 15, cc = c & 31, ob = rr * 64 + cc * 2; return st * 1024 + (ob ^ (((ob >> 9) & 1) << 5)); }
DI void stage_rc(int b, int& R, int& C) { const int st = b / 1024, sb = b % 1024, swz = sb ^ (((sb >> 9) & 1) << 5); R = (st >> 1) * 16 + swz / 64; C = (st & 1) * 32 + (swz % 64) / 2; }
DI int perm32(int rho) { const int n = rho >> 4, i = rho & 15; return 8 * (i >> 2) + 4 * n + (i & 3); }
struct Unit { int pm, pn, k0, nt, kind; };
struct Gemm { const bf16_t* A; const bf16_t* Bt; int lda, ldb, K, nM, nN, a_pn_off; const bf16_t* A2; const bf16_t* Bt2; };
struct StaticOrder {
    int nM, nN, nwg, G, c, ntK, nsl, nsplit, nM2, nN2, nwg2;
    DI void init(int nM_, int nN_, int G_, int c_, int K_, int nTail = 0, int nM2_ = 0, int nN2_ = 0) { nM = nM_; nN = nN_; nwg = nM * nN; G = G_; c = c_; ntK = K_ / BK; nsl = K_ / 256; nsplit = nTail * nN_ * nsl; nM2 = nM2_; nN2 = nN2_; nwg2 = nM2_ * nN2_; }
    DI static void tile(int wgid, int nwg_, int nM_, int nN_, Unit& u) {
        { const int q = nwg_ / NXCD, r = nwg_ % NXCD, xcd = wgid % NXCD, off = wgid / NXCD; wgid = (xcd < r ? xcd * (q + 1) : r * (q + 1) + (xcd - r) * q) + off; }
        const int nig = WGM * nN_, gid = wgid / nig, fm = gid * WGM, gsz = (nM_ - fm) < WGM ? (nM_ - fm) : WGM;
        u.pm = fm + ((wgid % nig) % gsz); u.pn = (wgid % nig) / gsz;
    }
    DI bool next(int i, Unit& u) const {
        const long L = (long)i * G + c; if (L >= nwg + nwg2 + nsplit) return false;
        u.k0 = 0; u.nt = ntK; u.kind = 0;
        if (L < nwg) { tile((int)L, nwg, nM, nN, u); return true; }
        if (L < nwg + nwg2) { tile((int)L - nwg, nwg2, nM2, nN2, u); u.kind = 1; return true; }
        const int L2 = (int)L - nwg - nwg2; const int sl = L2 % nsl, tl = L2 / nsl; u.pm = nM + (tl & 3); u.pn = tl >> 2; u.k0 = sl * 256; u.nt = 4; return true;
    }
};
template <class Epi>
DI void gemm_phase(LAS unsigned char* lds, const Gemm g, const StaticOrder S, const Epi E) {
    const int tid = tid_opaque(), wid = __builtin_amdgcn_readfirstlane(tid >> 6), lane = tid & 63, wr = wid >> 2, wc = wid & 3, fr = lane & 15, fq = lane >> 4;
    unsigned voffA[2], voffB[2];
#pragma unroll
    for (int i = 0; i < 2; ++i) { int R, C; stage_rc(tid * 16 + i * 8192, R, C); const int Rb = Epi::PERM ? ((R & ~31) + perm32(R & 31)) : R;
        voffA[i] = (unsigned)(R * g.lda + C) * 2u; voffB[i] = (unsigned)(Rb * g.ldb + C) * 2u; }
    const size_t kstep = (size_t)(BK * 2);
    const size_t hstepA = (size_t)HALF * g.lda * 2, hstepB = (size_t)HALF * g.ldb * 2;
    const size_t tstepA = 2 * hstepA, tstepB = 2 * hstepB;
    const size_t pnoffA = (size_t)g.a_pn_off * 2;
    const unsigned ldsw = (unsigned)wid * 1024u;
    const int aoff = lds_byte(wr * 64 + fr, fq * 8), boff = lds_byte(wc * 32 + fr, fq * 8);
#define PG8_SA(b, h) (((b) * 2 + (h)) * HTB)
#define PG8_SB(b, h) ((4 + (b) * 2 + (h)) * HTB)
#define PG8_STAGE(bufoff, gbase, voff) do { _Pragma("unroll") for (int _i = 0; _i < 2; ++_i) \
        __builtin_amdgcn_global_load_lds((const unsigned*)((const char*)(gbase) + (voff)[_i]), (LAS unsigned*)(lds + (bufoff) + ldsw + _i * 8192), 16, 0, 0); } while (0)
#define PG8_LDA(dst, b, h) do { _Pragma("unroll") for (int m = 0; m < 4; ++m) _Pragma("unroll") for (int k = 0; k < 2; ++k) dst[m][k] = *(const LAS bf16x8*)(lds + PG8_SA(b, h) + aoff + m * 2048 + k * 1024); } while (0)
#define PG8_LDB(dst, b, h) do { _Pragma("unroll") for (int n = 0; n < 2; ++n) _Pragma("unroll") for (int k = 0; k < 2; ++k) dst[n][k] = *(const LAS bf16x8*)(lds + PG8_SB(b, h) + boff + n * 2048 + k * 1024); } while (0)
#define PG8_MMA(ai, bj, At, Bt) do { __builtin_amdgcn_s_setprio(1); _Pragma("unroll") for (int m = 0; m < 4; ++m) _Pragma("unroll") for (int n = 0; n < 2; ++n) _Pragma("unroll") for (int k = 0; k < 2; ++k) \
        acc[ai][bj][m][n] = __builtin_amdgcn_mfma_f32_16x16x32_bf16(Bt[n][k], At[m][k], acc[ai][bj][m][n], 0, 0, 0); __builtin_amdgcn_s_setprio(0); } while (0)
#define PG8_WAIT_V(n) asm volatile("s_waitcnt vmcnt(" #n ")" ::: "memory")
#define PG8_WAIT_L(n) asm volatile("s_waitcnt lgkmcnt(" #n ")" ::: "memory")
#define PG8_BAR __builtin_amdgcn_s_barrier()
#define PG8_SCHED __builtin_amdgcn_sched_barrier(0)
    Unit cur, nxt; int ui = 0;
    if (!S.next(0, cur)) return;
    f32x4 acc[2][2][4][2];
#pragma unroll
    for (int a = 0; a < 2; ++a)
#pragma unroll
        for (int b = 0; b < 2; ++b)
#pragma unroll
            for (int m = 0; m < 4; ++m)
#pragma unroll
                for (int n = 0; n < 2; ++n) acc[a][b][m][n] = (f32x4){0.f, 0.f, 0.f, 0.f};
    bf16x8 At[4][2], B0[2][2], B1[2][2];
    const char* cA = (const char*)(cur.kind ? g.A2 : g.A) + (size_t)cur.pm * tstepA + (size_t)cur.pn * pnoffA + (size_t)cur.k0 * 2; const char* cB = (const char*)(cur.kind ? g.Bt2 : g.Bt) + (size_t)cur.pn * tstepB + (size_t)cur.k0 * 2;
    PG8_STAGE(PG8_SB(0, 0), cB, voffB); PG8_STAGE(PG8_SB(0, 1), cB + hstepB, voffB); PG8_STAGE(PG8_SA(0, 0), cA, voffA); PG8_STAGE(PG8_SA(0, 1), cA + hstepA, voffA);
    if (wr == 1) PG8_BAR;
    PG8_WAIT_V(2); PG8_BAR;
    PG8_STAGE(PG8_SB(1, 0), cB + kstep, voffB); PG8_STAGE(PG8_SA(1, 0), cA + kstep, voffA); PG8_STAGE(PG8_SB(1, 1), cB + hstepB + kstep, voffB);
    PG8_WAIT_V(6); PG8_BAR;
    for (;;) {
        const bool has_next = S.next(ui + 1, nxt);
        const char* nA = has_next ? (const char*)(nxt.kind ? g.A2 : g.A) + (size_t)nxt.pm * tstepA + (size_t)nxt.pn * pnoffA + (size_t)nxt.k0 * 2 : cA; const char* nB = has_next ? (const char*)(nxt.kind ? g.Bt2 : g.Bt) + (size_t)nxt.pn * tstepB + (size_t)nxt.k0 * 2 : cB;
        const int nt = cur.nt;
        for (int t = 0; t < nt; t += 2) {
            const bool last = (t == nt - 2);
            const char* a1 = cA + (size_t)(t + 1) * kstep;
            const char* a2 = last ? nA : cA + (size_t)(t + 2) * kstep; const char* b2 = last ? nB : cB + (size_t)(t + 2) * kstep;
            const char* a3 = a2 + kstep; const char* b3 = b2 + kstep;
            PG8_LDB(B0, 0, 0); PG8_LDB(B1, 0, 1); PG8_SCHED; PG8_LDA(At, 0, 0); PG8_STAGE(PG8_SA(1, 1), a1 + hstepA, voffA);
            PG8_WAIT_V(8); PG8_WAIT_L(0); PG8_BAR; PG8_MMA(0, 0, At, B0); PG8_MMA(0, 1, At, B1); PG8_BAR; PG8_SCHED;
            PG8_LDA(At, 0, 1); PG8_STAGE(PG8_SB(0, 0), b2, voffB); PG8_STAGE(PG8_SB(0, 1), b2 + hstepB, voffB); PG8_STAGE(PG8_SA(0, 0), a2, voffA);
            PG8_WAIT_V(8); PG8_WAIT_L(0); PG8_BAR; PG8_MMA(1, 0, At, B0); PG8_MMA(1, 1, At, B1); PG8_BAR; PG8_SCHED;
            PG8_LDB(B0, 1, 0); PG8_LDB(B1, 1, 1); PG8_SCHED; PG8_LDA(At, 1, 0); PG8_STAGE(PG8_SA(0, 1), a2 + hstepA, voffA);
            PG8_WAIT_V(8); PG8_WAIT_L(0); PG8_BAR; PG8_MMA(0, 0, At, B0); PG8_MMA(0, 1, At, B1); PG8_BAR; PG8_SCHED;
            PG8_LDA(At, 1, 1); PG8_STAGE(PG8_SB(1, 0), b3, voffB); PG8_STAGE(PG8_SB(1, 1), b3 + hstepB, voffB); PG8_STAGE(PG8_SA(1, 0), a3, voffA);
            PG8_WAIT_V(8); PG8_WAIT_L(0); PG8_BAR; PG8_MMA(1, 0, At, B0); PG8_MMA(1, 1, At, B1); PG8_BAR; PG8_SCHED;
        }
        if (wr == 0) PG8_BAR;
        E(acc, cur, wr, wc, fr, fq);
        if (!has_next) break;
#pragma unroll
        for (int a = 0; a < 2; ++a)
#pragma unroll
            for (int b = 0; b < 2; ++b)
#pragma unroll
                for (int m = 0; m < 4; ++m)
#pragma unroll
                    for (int n = 0; n < 2; ++n) acc[a][b][m][n] = (f32x4){0.f, 0.f, 0.f, 0.f};
        cur = nxt; cA = nA; cB = nB; ++ui;
        if (wr == 1) PG8_BAR;
    }
    PG8_WAIT_V(0);
    PG8_BAR;
#undef PG8_SA
#undef PG8_SB
#undef PG8_STAGE
#undef PG8_LDA
#undef PG8_LDB
#undef PG8_MMA
#undef PG8_WAIT_V
#undef PG8_WAIT_L
#undef PG8_BAR
#undef PG8_SCHED
}
}
using pg8::Unit;
typedef f32x4 AccT[2][2][4][2];

struct EpiSwiglu {
    static constexpr bool PERM = true;
    bf16_t* O;
    DI void operator()(const AccT& acc, const Unit& u, int wr, int wc, int fr, int fq) const {
        asm volatile("" : "+v"(fr), "+v"(fq));
        const int row0 = u.pm * 256 + wr * 64 + fr, col0 = u.pn * 128 + wc * 32 + 8 * fq;
#pragma unroll
        for (int ai = 0; ai < 2; ++ai)
#pragma unroll
            for (int m = 0; m < 4; ++m) {
                bf16_t* p = O + (size_t)(row0 + ai * 128 + m * 16) * FF + col0;
                float v[8];
#pragma unroll
                for (int n = 0; n < 2; ++n)
#pragma unroll
                    for (int i = 0; i < 4; ++i) v[n * 4 + i] = silu_f(acc[ai][0][m][n][i]) * acc[ai][1][m][n][i];
                u32x4 w; w.x = pk2(v[0], v[1]); w.y = pk2(v[2], v[3]); w.z = pk2(v[4], v[5]); w.w = pk2(v[6], v[7]);
                *(u32x4*)p = w; __builtin_amdgcn_sched_barrier(0);
            }
    }
};
struct EpiResid {
    static constexpr bool PERM = true;
    float* H; const float* Hsrc; const float* gate; const float* colscale; float* P; float w; float pad_;
    DI void operator()(const AccT& acc, const Unit& u, int wr, int wc, int fr, int fq) const {
        asm volatile("" : "+v"(fr), "+v"(fq));
        const int mr = u.pm < 64 ? (u.pm >> 4) : 4; const bool split = u.pm >= 64;
        const int row0 = u.pm * 256 + wr * 64 + fr, col0 = u.pn * 256 + wc * 32 + 8 * fq;
        const float* g = gate + (size_t)mr * MODW + col0;
#pragma unroll
        for (int bj = 0; bj < 2; ++bj) {
            f32x4 g0 = *(const f32x4*)(g + bj * 128) * w, g1 = *(const f32x4*)(g + bj * 128 + 4) * w;
            if (colscale) { g0 = g0 * *(const f32x4*)(colscale + col0 + bj * 128); g1 = g1 * *(const f32x4*)(colscale + col0 + bj * 128 + 4); }
#pragma unroll
            for (int ai = 0; ai < 2; ++ai) {
                if (split) {
#pragma unroll
                    for (int m = 0; m < 4; ++m) {
                        float* q = P + ((size_t)(u.k0 >> 8) * MC + (row0 + ai * 128 + m * 16 - ML)) * D + col0 + bj * 128;
                        *(f32x4*)q = g0 * acc[ai][bj][m][0]; *(f32x4*)(q + 4) = g1 * acc[ai][bj][m][1];
                    }
                } else {
                    float* p = H + (size_t)(row0 + ai * 128) * D + col0 + bj * 128;
                    const float* ps = Hsrc + (size_t)(row0 + ai * 128) * D + col0 + bj * 128;
                    f32x4 h[4][2];
#pragma unroll
                    for (int m = 0; m < 4; ++m) { h[m][0] = *(const f32x4*)(ps + (size_t)m * 16 * D); h[m][1] = *(const f32x4*)(ps + (size_t)m * 16 * D + 4); }
#pragma unroll
                    for (int m = 0; m < 4; ++m) { h[m][0] = h[m][0] + g0 * acc[ai][bj][m][0]; h[m][1] = h[m][1] + g1 * acc[ai][bj][m][1]; }
#pragma unroll
                    for (int m = 0; m < 4; ++m) { *(f32x4*)(p + (size_t)m * 16 * D) = h[m][0]; *(f32x4*)(p + (size_t)m * 16 * D + 4) = h[m][1]; }
                }
                __builtin_amdgcn_sched_barrier(0);
            }
        }
    }
};
struct EpiBf16 {
    static constexpr bool PERM = true;
    bf16_t* O; int ldc; int nsc; float sc; int cm_rows; int pad_;
    DI void operator()(const AccT& acc, const Unit& u, int wr, int wc, int fr, int fq) const {
        asm volatile("" : "+v"(fr), "+v"(fq));
        const float s = u.pn < nsc ? sc : 1.f;
        const int row0 = u.pm * 256 + wr * 64 + fr, col0 = u.pn * 256 + wc * 32 + 8 * fq;
#pragma unroll
        for (int ai = 0; ai < 2; ++ai)
#pragma unroll
            for (int m = 0; m < 4; ++m)
#pragma unroll
                for (int bj = 0; bj < 2; ++bj) {
                    const int rr_ = row0 + ai * 128 + m * 16, cc_ = col0 + bj * 128;
                    bf16_t* p = cm_rows ? O + ((size_t)(cc_ >> 6) * cm_rows + rr_) * 64 + (cc_ & 63) : O + (size_t)rr_ * ldc + cc_;
                    const f32x4 v0 = acc[ai][bj][m][0] * s, v1 = acc[ai][bj][m][1] * s;
                    u32x4 w; w.x = pk2(v0[0], v0[1]); w.y = pk2(v0[2], v0[3]); w.z = pk2(v1[0], v1[1]); w.w = pk2(v1[2], v1[3]);
                    *(u32x4*)p = w; __builtin_amdgcn_sched_barrier(0);
                }
    }
};
struct EpiRetNat {
    static constexpr bool PERM = true;
    bf16_t* G; bf16_t* Q; bf16_t* Kb; const f32x2* cs;
    DI void operator()(const AccT& acc, const Unit& u, int wr, int wc, int fr, int fq) const {
        asm volatile("" : "+v"(fr), "+v"(fq));
        const int row0 = u.pm * 256 + wr * 64 + fr;
        if (u.pn < 8) {
            const int col0 = u.pn * 256 + wc * 32 + 8 * fq;
#pragma unroll
            for (int ai = 0; ai < 2; ++ai)
#pragma unroll
                for (int m = 0; m < 4; ++m)
#pragma unroll
                    for (int bj = 0; bj < 2; ++bj) {
                        bf16_t* p = G + (size_t)(row0 + ai * 128 + m * 16) * 2048 + col0 + bj * 128;
                        const f32x4 v0 = acc[ai][bj][m][0], v1 = acc[ai][bj][m][1];
                        u32x4 w; w.x = pk2(silu_f(v0[0]), silu_f(v0[1])); w.y = pk2(silu_f(v0[2]), silu_f(v0[3])); w.z = pk2(silu_f(v1[0]), silu_f(v1[1])); w.w = pk2(silu_f(v1[2]), silu_f(v1[3]));
                        *(u32x4*)p = w; __builtin_amdgcn_sched_barrier(0);
                    }
            return;
        }
        const bool isk = u.pn >= 12; const int head = (u.pn - 8) & 3; const float sc = isk ? 0.0625f : 1.f;
        bf16_t* dst = isk ? Kb : Q; const bool lat = u.pm < 64;
        const int dl0 = wc * 32 + 8 * fq;
#pragma unroll
        for (int ai = 0; ai < 2; ++ai)
#pragma unroll
            for (int m = 0; m < 4; ++m) {
                const int row = row0 + ai * 128 + m * 16;
                float x0[8], x1[8];
#pragma unroll
                for (int n = 0; n < 2; ++n)
#pragma unroll
                    for (int i = 0; i < 4; ++i) { x0[n * 4 + i] = acc[ai][0][m][n][i] * sc; x1[n * 4 + i] = acc[ai][1][m][n][i] * sc; }
                if (lat) {
                    const f32x4* cp = (const f32x4*)(cs + (size_t)(row & 4095) * 128 + dl0);
#pragma unroll
                    for (int q = 0; q < 4; ++q) { const f32x4 c = cp[q];
                        const float a0 = x0[2 * q], b0 = x1[2 * q], a1 = x0[2 * q + 1], b1 = x1[2 * q + 1];
                        x0[2 * q] = a0 * c[0] - b0 * c[1]; x1[2 * q] = b0 * c[0] + a0 * c[1];
                        x0[2 * q + 1] = a1 * c[2] - b1 * c[3]; x1[2 * q + 1] = b1 * c[2] + a1 * c[3]; }
                }
                bf16_t* p = dst + (size_t)row * 1024 + head * 256 + dl0;
                u32x4 w0, w1; w0.x = pk2(x0[0], x0[1]); w0.y = pk2(x0[2], x0[3]); w0.z = pk2(x0[4], x0[5]); w0.w = pk2(x0[6], x0[7]);
                w1.x = pk2(x1[0], x1[1]); w1.y = pk2(x1[2], x1[3]); w1.z = pk2(x1[4], x1[5]); w1.w = pk2(x1[6], x1[7]);
                *(u32x4*)p = w0; *(u32x4*)(p + 128) = w1;
            }
    }
};
struct EpiRetSwp {
    static constexpr bool PERM = true;
    bf16_t* KTf; bf16_t* KTb; bf16_t* VT; const f32x2* csT; const float* dec;
    DI void operator()(const AccT& acc, const Unit& u, int wr, int wc, int fr, int fq) const {
        asm volatile("" : "+v"(fr), "+v"(fq));
        const int col0 = u.pn * 256 + wc * 32 + 8 * fq;
        if (u.pm >= 4) {
            const int row0 = (u.pm - 4) * 256 + wr * 64 + fr;
#pragma unroll
            for (int ai = 0; ai < 2; ++ai)
#pragma unroll
                for (int m = 0; m < 4; ++m)
#pragma unroll
                    for (int bj = 0; bj < 2; ++bj) {
                        const int cc_ = col0 + bj * 128; bf16_t* p = VT + ((size_t)(cc_ >> 6) * 2048 + (row0 + ai * 128 + m * 16)) * 64 + (cc_ & 63);
                        const f32x4 v0 = acc[ai][bj][m][0], v1 = acc[ai][bj][m][1];
                        u32x4 w; w.x = pk2(v0[0], v0[1]); w.y = pk2(v0[2], v0[3]); w.z = pk2(v1[0], v1[1]); w.w = pk2(v1[2], v1[3]);
                        *(u32x4*)p = w; __builtin_amdgcn_sched_barrier(0);
                    }
            return;
        }
        const int head = u.pm; const bool lat = u.pn < 64;
        const int pos0 = 32 * (wc & 1) + 8 * fq;
        const float lgf = dec[head], lgb = dec[4 + head];
        float kdf[8], kdb[8];
#pragma unroll
        for (int e = 0; e < 8; ++e) { kdf[e] = 0.0625f * __builtin_amdgcn_exp2f(lgf * (float)(63 - pos0 - e)); kdb[e] = 0.0625f * __builtin_amdgcn_exp2f(lgb * (float)(pos0 + e)); }
#pragma unroll
        for (int m = 0; m < 4; ++m) {
            const int dl = wr * 64 + m * 16 + fr;
#pragma unroll
            for (int bj = 0; bj < 2; ++bj) {
                const int c0 = col0 + bj * 128;
                const f32x4* cp = (const f32x4*)(csT + (size_t)dl * 4096 + (c0 & 4095));
                const size_t o0 = ((size_t)(c0 >> 6) * 1024 + head * 256 + dl) * 64 + (c0 & 63), o1 = o0 + (size_t)128 * 64;
                float p[8], q[8];
#pragma unroll
                for (int n = 0; n < 2; ++n) {
                    f32x4 ca = (f32x4){1.f, 0.f, 1.f, 0.f}, cb = ca;
                    if (lat) { ca = cp[2 * n]; cb = cp[2 * n + 1]; }
                    const f32x4 x0 = acc[0][bj][m][n], x1 = acc[1][bj][m][n];
                    p[4 * n + 0] = x0[0] * ca[0] - x1[0] * ca[1]; q[4 * n + 0] = x1[0] * ca[0] + x0[0] * ca[1];
                    p[4 * n + 1] = x0[1] * ca[2] - x1[1] * ca[3]; q[4 * n + 1] = x1[1] * ca[2] + x0[1] * ca[3];
                    p[4 * n + 2] = x0[2] * cb[0] - x1[2] * cb[1]; q[4 * n + 2] = x1[2] * cb[0] + x0[2] * cb[1];
                    p[4 * n + 3] = x0[3] * cb[2] - x1[3] * cb[3]; q[4 * n + 3] = x1[3] * cb[2] + x0[3] * cb[3];
                }
                u32x4 w;
                w.x = pk2(p[0] * kdf[0], p[1] * kdf[1]); w.y = pk2(p[2] * kdf[2], p[3] * kdf[3]); w.z = pk2(p[4] * kdf[4], p[5] * kdf[5]); w.w = pk2(p[6] * kdf[6], p[7] * kdf[7]); *(u32x4*)(KTf + o0) = w;
                w.x = pk2(q[0] * kdf[0], q[1] * kdf[1]); w.y = pk2(q[2] * kdf[2], q[3] * kdf[3]); w.z = pk2(q[4] * kdf[4], q[5] * kdf[5]); w.w = pk2(q[6] * kdf[6], q[7] * kdf[7]); *(u32x4*)(KTf + o1) = w;
                w.x = pk2(p[0] * kdb[0], p[1] * kdb[1]); w.y = pk2(p[2] * kdb[2], p[3] * kdb[3]); w.z = pk2(p[4] * kdb[4], p[5] * kdb[5]); w.w = pk2(p[6] * kdb[6], p[7] * kdb[7]); *(u32x4*)(KTb + o0) = w;
                w.x = pk2(q[0] * kdb[0], q[1] * kdb[1]); w.y = pk2(q[2] * kdb[2], q[3] * kdb[3]); w.z = pk2(q[4] * kdb[4], q[5] * kdb[5]); w.w = pk2(q[6] * kdb[6], q[7] * kdb[7]); *(u32x4*)(KTb + o1) = w;

            }
        }
    }
};
struct EpiSwaNat {
    static constexpr bool PERM = true; static constexpr bool HOOK = false;
    bf16_t* O; const f32x2* cs2;
    DI void operator()(const AccT& acc, const Unit& u, int wr, int wc, int fr, int fq) const {
        asm volatile("" : "+v"(fr), "+v"(fq));
        const float sc = u.pn < 4 ? 0.125f : 1.f; const bool lat = u.pm < 64; const int axis = wc & 1;
        const int row0 = u.pm * 256 + wr * 64 + fr, col0 = u.pn * 256 + wc * 32 + 8 * fq;
        const int lane = fr + 16 * fq; const float sgn = (fq >> 1) ? 1.f : -1.f;
#pragma unroll
        for (int ai = 0; ai < 2; ++ai)
#pragma unroll
            for (int m = 0; m < 4; ++m) {
                const int row = row0 + ai * 128 + m * 16; const int t = row & 4095; const int pos = axis ? (t & 63) : (t >> 6);
                f32x4 c0 = (f32x4){1.f, 0.f, 1.f, 0.f}, c1 = c0, c2 = c0, c3 = c0;
                if (lat) { const f32x4* cp = (const f32x4*)(cs2 + pos * 16 + 8 * (fq & 1)); c0 = cp[0]; c1 = cp[1]; c2 = cp[2]; c3 = cp[3]; }
#pragma unroll
                for (int bj = 0; bj < 2; ++bj) {
                    const f32x4 x0 = acc[ai][bj][m][0], x1 = acc[ai][bj][m][1];
                    f32x4 y0, y1;
#pragma unroll
                    for (int i = 0; i < 4; ++i) { y0[i] = shx(x0[i], 32, lane); y1[i] = shx(x1[i], 32, lane); }
                    float o[8];
                    o[0] = x0[0] * c0[0] + sgn * y0[0] * c0[1]; o[1] = x0[1] * c0[2] + sgn * y0[1] * c0[3];
                    o[2] = x0[2] * c1[0] + sgn * y0[2] * c1[1]; o[3] = x0[3] * c1[2] + sgn * y0[3] * c1[3];
                    o[4] = x1[0] * c2[0] + sgn * y1[0] * c2[1]; o[5] = x1[1] * c2[2] + sgn * y1[1] * c2[3];
                    o[6] = x1[2] * c3[0] + sgn * y1[2] * c3[1]; o[7] = x1[3] * c3[2] + sgn * y1[3] * c3[3];
                    bf16_t* p = O + (size_t)row * 1280 + col0 + bj * 128;
                    u32x4 w; w.x = pk2(o[0] * sc, o[1] * sc); w.y = pk2(o[2] * sc, o[3] * sc); w.z = pk2(o[4] * sc, o[5] * sc); w.w = pk2(o[6] * sc, o[7] * sc);
                    *(u32x4*)p = w;
                }
            }
    }
};
template <class E1, class E2> struct EpiDual {
    static constexpr bool PERM = true, HOOK = false;
    E1 e1; E2 e2;
    DI void operator()(const AccT& acc, const Unit& u, int wr, int wc, int fr, int fq) const { if (u.kind) e2(acc, u, wr, wc, fr, fq); else e1(acc, u, wr, wc, fr, fq); }
};
struct Args { const float* in[23]; float* out; unsigned char* ws; int ph_lo, ph_hi; };
struct Ctx { unsigned char* ws; float* out; const float* normg; const float* fng; const float* rgn; const float* aux_nat; const float* aux_swa; const float* psc; const float* x; const float* ctx; };
DI const float* inp_ld(const unsigned char* ws, int i) { const unsigned long long p = ((const unsigned long long*)(ws + OFF_PTAB))[i];
    const unsigned lo = __builtin_amdgcn_readfirstlane((unsigned)p), hi = __builtin_amdgcn_readfirstlane((unsigned)(p >> 32)); return (const float*)(const __attribute__((address_space(1))) float*)(((unsigned long long)hi << 32) | lo); }
#define INP(a_, i_) inp_ld((a_).ws, (i_))
enum { I_X = 0, I_C, I_CTX, I_CCTX, I_WMOD, I_BMOD, I_NORMG, I_FWIN, I_FWOUT, I_RWIN, I_RWOUT, I_RGN, I_RDF, I_RDB, I_NWQKV, I_NWO, I_NRPB, I_PW, I_PSC, I_SWQKV, I_SWO, I_SSINK, I_FNG };

DI void transpose_item(const float* W, int K, int N, bf16_t* WT, int maptype, LAS float* scr, int item, int lane) {
    const int nblk = N / 64, kb = item / nblk, nb = item % nblk, k0 = 64 * kb, n0 = 64 * nb;
    int d0 = n0;
    if (maptype == 1) { const int j = n0 < FF ? n0 : n0 - FF; d0 = (j >> 7) * 256 + (n0 < FF ? 0 : 128) + (j & 127); }
    else if (maptype == 2) { d0 = n0 < 4096 ? n0 + 2048 : n0 - 4096; }
    const int lr = lane >> 4, lc = 4 * (lane & 15);
    f32x4 v[16];
#pragma unroll
    for (int i = 0; i < 16; ++i) v[i] = __builtin_nontemporal_load((const f32x4*)(W + (size_t)(k0 + 4 * i + lr) * N + n0 + lc));
#pragma unroll
    for (int i = 0; i < 16; ++i) { LAS float* p = scr + (4 * i + lr) * 65 + lc; p[0] = v[i][0]; p[1] = v[i][1]; p[2] = v[i][2]; p[3] = v[i][3]; }
    asm volatile("s_waitcnt lgkmcnt(0)" ::: "memory");
    const int c = lane & 7;
#pragma unroll
    for (int j = 0; j < 8; ++j) { const int n = (lane >> 3) + 8 * j; const LAS float* q = scr + (8 * c) * 65 + n;
        u32x4 o; o.x = pk2(q[0 * 65], q[1 * 65]); o.y = pk2(q[2 * 65], q[3 * 65]); o.z = pk2(q[4 * 65], q[5 * 65]); o.w = pk2(q[6 * 65], q[7 * 65]);
        *(u32x4*)(WT + (size_t)(d0 + n) * K + k0 + 8 * c) = o; }
    asm volatile("s_waitcnt lgkmcnt(0)" ::: "memory");
}

DI void prologue(const Args& a, LAS unsigned char* lds) {
    unsigned char* ws = a.ws;
    const int tid = tid_opaque(), lane = tid & 63, wave = tid >> 6;
    const int G = gridDim.x, gw = blockIdx.x * NWAVES + wave, NGW = G * NWAVES, gtid = blockIdx.x * NTHREADS + tid, NT = G * NTHREADS;
    if (blockIdx.x == 0 && tid < 23) ((const float**)(ws + OFF_PTAB))[tid] = a.in[tid];
    {
        f32x2* cs = (f32x2*)(ws + OFF_CS); f32x2* csT = (f32x2*)(ws + OFF_CST); f32x2* cs2 = (f32x2*)(ws + OFF_CS2); float* dec = (float*)(ws + OFF_DEC);
        for (int idx = gtid; idx < 4096 * 128; idx += NT) {
            const int t = idx >> 7, dl = idx & 127;
            const float inv = exp2f(-(float)dl * (13.287712379549449f / 128.f));
            const float ang = (float)t * inv;
            double rev = (double)ang * 0.15915494309189535; rev -= floor(rev);
            const float fr_ = (float)rev;
            f32x2 v; v.x = __builtin_amdgcn_cosf(fr_); v.y = __builtin_amdgcn_sinf(fr_);
            cs[idx] = v; csT[(size_t)dl * 4096 + t] = v;
        }
        if (gtid < 1024) {
            const int pos = gtid >> 4, f = gtid & 15;
            const float inv = exp2f(-(float)f * (13.287712379549449f / 16.f));
            const float ang = (float)pos * inv;
            double rev = (double)ang * 0.15915494309189535; rev -= floor(rev);
            const float fr_ = (float)rev;
            f32x2 v; v.x = __builtin_amdgcn_cosf(fr_); v.y = __builtin_amdgcn_sinf(fr_);
            cs2[gtid] = v;
        }
        if (gtid < 8) { const float x = gtid < 4 ? a.in[I_RDF][gtid] : a.in[I_RDB][gtid - 4]; dec[gtid] = -log1pf(expf(-x)) * LOG2E; }
    }
    {
        LAS float* scr = (LAS float*)(lds + wave * 16640);
        constexpr int I_FI = 16 * 88, I_FO = 44 * 16, I_RI = 16 * 96, I_RO = 32 * 16, I_NQ = 16 * 48, I_NO = 16 * 16, I_PL = 4 * 4, I_SQ = 16 * 24, I_SO = 16 * 16;
        constexpr int NITEMS = 8 * I_FI + 8 * I_FO + I_RI + I_RO + I_NQ + I_NO + 4 * I_PL + I_SQ + I_SO;
        for (int it = gw; it < NITEMS; it += NGW) {
            int r = it;
            if (r < 8 * I_FI) { const int mi = r / I_FI; transpose_item(a.in[I_FWIN] + (size_t)mi * 1024 * 5632, 1024, 5632, (bf16_t*)(ws + OFF_WFI) + (size_t)mi * 5632 * 1024, 1, scr, r % I_FI, lane); continue; } r -= 8 * I_FI;
            if (r < 8 * I_FO) { const int mi = r / I_FO; transpose_item(a.in[I_FWOUT] + (size_t)mi * 2816 * 1024, 2816, 1024, (bf16_t*)(ws + OFF_WFO) + (size_t)mi * 1024 * 2816, 0, scr, r % I_FO, lane); continue; } r -= 8 * I_FO;
            if (r < I_RI) { transpose_item(a.in[I_RWIN], 1024, 6144, (bf16_t*)(ws + OFF_WRI), 2, scr, r, lane); continue; } r -= I_RI;
            if (r < I_RO) { transpose_item(a.in[I_RWOUT], 2048, 1024, (bf16_t*)(ws + OFF_WRO), 0, scr, r, lane); continue; } r -= I_RO;
            if (r < I_NQ) { transpose_item(a.in[I_NWQKV], 1024, 3072, (bf16_t*)(ws + OFF_WNQ), 0, scr, r, lane); continue; } r -= I_NQ;
            if (r < I_NO) { transpose_item(a.in[I_NWO], 1024, 1024, (bf16_t*)(ws + OFF_WNO), 0, scr, r, lane); continue; } r -= I_NO;
            if (r < 4 * I_PL) { const int mi = r / I_PL; transpose_item(a.in[I_PW] + (size_t)mi * 65536, 256, 256, (bf16_t*)(ws + OFF_WPL) + (size_t)mi * 65536, 0, scr, r % I_PL, lane); continue; } r -= 4 * I_PL;
            if (r < I_SQ) { transpose_item(a.in[I_SWQKV], 1024, 1536, (bf16_t*)(ws + OFF_WSQ), 0, scr, r, lane); continue; } r -= I_SQ;
            transpose_item(a.in[I_SWO], 1024, 1024, (bf16_t*)(ws + OFF_WSO), 0, scr, r, lane);
        }
    }
    __syncthreads();
    {
        LAS float* sv = (LAS float*)lds;
        LAS float* part = (LAS float*)(lds + 5 * 1024 * 4);
        for (int i = tid; i < 5 * 1024; i += NTHREADS) { const float x = i < 4096 ? a.in[I_C][i] : a.in[I_CCTX][i - 4096]; sv[i] = x / (1.f + expf(-x)); }
        __syncthreads();
        float* mod = (float*)(ws + OFF_MOD);
        for (int it = blockIdx.x; it < 4 * 36 * 8; it += G) {
            const int kq = it & 7, cb = (it >> 3) % 36, l = it / 288;
            const int kr0 = kq * 128 + wave * 16;
            const float* wp = a.in[I_WMOD] + (size_t)l * 1024 * MODW + (size_t)kr0 * MODW + cb * 256 + 4 * lane;
            f32x4 wv[16];
#pragma unroll
            for (int k = 0; k < 16; ++k) wv[k] = __builtin_nontemporal_load((const f32x4*)(wp + (size_t)k * MODW));
            f32x4 acc[5];
#pragma unroll
            for (int r = 0; r < 5; ++r) acc[r] = (f32x4){0.f, 0.f, 0.f, 0.f};
#pragma unroll
            for (int k = 0; k < 16; ++k)
#pragma unroll
                for (int r = 0; r < 5; ++r) acc[r] = acc[r] + wv[k] * sv[r * 1024 + kr0 + k];
#pragma unroll
            for (int r = 0; r < 5; ++r) *(LAS f32x4*)(part + (wave * 5 + r) * 256 + 4 * lane) = acc[r];
            __syncthreads();
            for (int o = tid; o < 5 * 256; o += NTHREADS) { const int r = o >> 8, c = o & 255; float sum = 0.f;
#pragma unroll
                for (int w8 = 0; w8 < 8; ++w8) sum += part[(w8 * 5 + r) * 256 + c];
                if (kq == 0) sum += a.in[I_BMOD][(size_t)l * MODW + cb * 256 + c];
                unsafeAtomicAdd(mod + ((size_t)l * 5 + r) * MODW + cb * 256 + c, sum); }
            __syncthreads();
        }
    }
}

DI void norm_phase(const Ctx& a, int layer, int sub, bool first, const float* P, int nsl, int nrows) {
    const int tid_ = tid_opaque(); const int lane = tid_ & 63, gw = blockIdx.x * NWAVES + (tid_ >> 6), NGW = gridDim.x * NWAVES;
    float* H = (float*)(a.ws + OFF_H); bf16_t* XN = (bf16_t*)(a.ws + OFF_XN);
    const float* g = a.normg + (size_t)(layer * 3 + sub) * 1024;
    const float* modl = (const float*)(a.ws + OFF_MOD) + (size_t)layer * 5 * MODW + (sub * 3) * 1024;
    const float* px = a.x; const float* pc = a.ctx;
    const int rbeg = gw, rend = nrows;
    if (rbeg >= rend) return;
#define NP_SRC(r_) (first ? ((r_) < ML ? px + (size_t)(r_) * 1024 : pc + (size_t)((r_) - ML) * 1024) : H + (size_t)(r_) * 1024)
#define NP_LOAD(dst_, r_) do { const float* s_ = NP_SRC(r_); _Pragma("unroll") for (int j = 0; j < 4; ++j) dst_[j] = *(const f32x4*)(s_ + 4 * lane + 256 * j); } while (0)
    f32x4 gg[4], sc[4], sh[4], v[4], n1[4], n2[4];
#pragma unroll
    for (int j = 0; j < 4; ++j) { gg[j] = *(const f32x4*)(g + 4 * lane + 256 * j); n1[j] = (f32x4){0.f, 0.f, 0.f, 0.f}; n2[j] = n1[j]; sc[j] = n1[j]; sh[j] = n1[j]; }
    NP_LOAD(n1, rbeg);
    if (rbeg + NGW < rend) NP_LOAD(n2, rbeg + NGW);
    int mr_cur = -1, mr_nxt = -1; f32x4 scn[4], shn[4];
#pragma unroll
    for (int j = 0; j < 4; ++j) { scn[j] = (f32x4){0.f, 0.f, 0.f, 0.f}; shn[j] = scn[j]; }
    for (int row = rbeg; row < rend; row += NGW) {
#pragma unroll
        for (int j = 0; j < 4; ++j) { v[j] = n1[j]; n1[j] = n2[j]; }
        if (row + 2 * NGW < rend) NP_LOAD(n2, row + 2 * NGW);
        const int mr = row < ML ? (row >> 12) : 4;
        if (mr != mr_cur) {
            if (mr == mr_nxt) {
#pragma unroll
                for (int j = 0; j < 4; ++j) { sh[j] = shn[j]; sc[j] = scn[j]; }
            } else {
#pragma unroll
                for (int j = 0; j < 4; ++j) { sh[j] = *(const f32x4*)(modl + (size_t)mr * MODW + 4 * lane + 256 * j); sc[j] = *(const f32x4*)(modl + (size_t)mr * MODW + 1024 + 4 * lane + 256 * j) + 1.f; }
            }
            mr_cur = mr;
        }
        if (row + 2 * NGW < rend) {
            const int r2_ = row + 2 * NGW; const int mr2 = r2_ < ML ? (r2_ >> 12) : 4;
            if (mr2 != mr_cur && mr2 != mr_nxt) { mr_nxt = mr2;
#pragma unroll
                for (int j = 0; j < 4; ++j) { shn[j] = *(const f32x4*)(modl + (size_t)mr2 * MODW + 4 * lane + 256 * j); scn[j] = *(const f32x4*)(modl + (size_t)mr2 * MODW + 1024 + 4 * lane + 256 * j) + 1.f; } }
        }
        const bool fold = !first && row >= ML;
        float ss = 0.f;
        if (fold) {
            for (int sl0 = 0; sl0 < nsl; sl0 += 4) {
                f32x4 t[4][4]; float wq[4];
#pragma unroll
                for (int u = 0; u < 4; ++u) { const int sl = sl0 + u < nsl ? sl0 + u : nsl - 1; wq[u] = sl0 + u < nsl ? 1.f : 0.f;
#pragma unroll
                    for (int j = 0; j < 4; ++j) t[u][j] = *(const f32x4*)(P + ((size_t)sl * MC + (row - ML)) * D + 4 * lane + 256 * j); }
#pragma unroll
                for (int u = 0; u < 4; ++u)
#pragma unroll
                    for (int j = 0; j < 4; ++j) v[j] = v[j] + t[u][j] * wq[u];
            }
        }
#pragma unroll
        for (int j = 0; j < 4; ++j) ss += (v[j][0] * v[j][0] + v[j][1] * v[j][1]) + (v[j][2] * v[j][2] + v[j][3] * v[j][3]);
        const float rstd = 1.f / sqrtf(wave_sum(ss, lane) * (1.f / 1024.f) + 1e-6f);
#pragma unroll
        for (int j = 0; j < 4; ++j) {
            const int c = 4 * lane + 256 * j;
            if ((first && row >= ML) || fold) *(f32x4*)(H + (size_t)row * 1024 + c) = v[j];
            f32x4 y = v[j] * rstd * gg[j]; y = y * sc[j] + sh[j];
            u32x2 w; w.x = pk2(y[0], y[1]); w.y = pk2(y[2], y[3]);
            *(u32x2*)(XN + (size_t)row * 1024 + c) = w;
        }
    }
#undef NP_LOAD
#undef NP_SRC
}
DI void final_phase(const Ctx& a) {
    const int tid_ = tid_opaque(); const int lane = tid_ & 63, gw = blockIdx.x * NWAVES + (tid_ >> 6), NGW = gridDim.x * NWAVES;
    const float* H = (const float*)(a.ws + OFF_H); const float* g = a.fng;
    if (gw >= ML) return;
    f32x4 gg[4], v[4], n1[4], n2[4];
#pragma unroll
    for (int j = 0; j < 4; ++j) { gg[j] = *(const f32x4*)(g + 4 * lane + 256 * j); n1[j] = *(const f32x4*)(H + (size_t)gw * 1024 + 4 * lane + 256 * j); n2[j] = n1[j]; }
    if (gw + NGW < ML) {
#pragma unroll
        for (int j = 0; j < 4; ++j) n2[j] = *(const f32x4*)(H + (size_t)(gw + NGW) * 1024 + 4 * lane + 256 * j); }
    for (int row = gw; row < ML; row += NGW) {
#pragma unroll
        for (int j = 0; j < 4; ++j) { v[j] = n1[j]; n1[j] = n2[j]; }
        if (row + 2 * NGW < ML) {
#pragma unroll
            for (int j = 0; j < 4; ++j) n2[j] = *(const f32x4*)(H + (size_t)(row + 2 * NGW) * 1024 + 4 * lane + 256 * j); }
        float ss = 0.f;
#pragma unroll
        for (int j = 0; j < 4; ++j) ss += (v[j][0] * v[j][0] + v[j][1] * v[j][1]) + (v[j][2] * v[j][2] + v[j][3] * v[j][3]);
        const float rstd = 1.f / sqrtf(wave_sum(ss, lane) * (1.f / 1024.f) + 1e-6f);
#pragma unroll
        for (int j = 0; j < 4; ++j) { const int c = 4 * lane + 256 * j; *(f32x4*)(a.out + (size_t)row * 1024 + c) = v[j] * rstd * gg[j]; }
    }
}

DI void pool_phase(const Ctx& a) {
    const bf16_t* XN = (const bf16_t*)(a.ws + OFF_XN); bf16_t* PL = (bf16_t*)(a.ws + OFF_PL);
    const int NT = gridDim.x * NTHREADS;
    const int G_ = gridDim.x, vb_ = (G_ % 8 == 0) ? (int)(blockIdx.x % 8) * (G_ / 8) + (int)(blockIdx.x / 8) : (int)blockIdx.x;
    for (int idx = vb_ * NTHREADS + tid_opaque(); idx < MT * 128; idx += NT) {
        const int row = idx >> 7, cg8 = idx & 127, half = 1 << (cg8 >> 5);
        int base, t, T;
        if (row < ML) { base = row & ~4095; t = row & 4095; T = 4096; } else { const int rr = row - ML; base = ML + (rr & ~255); t = rr & 255; T = 256; }
        const int lo = t - half < 0 ? 0 : t - half, hi = t + half > T ? T : t + half;
        float s[8] = {0.f, 0.f, 0.f, 0.f, 0.f, 0.f, 0.f, 0.f};
        for (int uu = lo; uu < hi; uu += 4) {
            u32x4 v[4]; float wgt[4];
#pragma unroll
            for (int e = 0; e < 4; ++e) { const int ur = uu + e < hi ? uu + e : hi - 1; wgt[e] = uu + e < hi ? 1.f : 0.f; v[e] = *(const u32x4*)(XN + (size_t)(base + ur) * 1024 + cg8 * 8); }
#pragma unroll
            for (int e = 0; e < 4; ++e) { s[0] += wgt[e] * bflo(v[e].x); s[1] += wgt[e] * bfhi(v[e].x); s[2] += wgt[e] * bflo(v[e].y); s[3] += wgt[e] * bfhi(v[e].y);
                s[4] += wgt[e] * bflo(v[e].z); s[5] += wgt[e] * bfhi(v[e].z); s[6] += wgt[e] * bflo(v[e].w); s[7] += wgt[e] * bfhi(v[e].w); }
        }
        const float inv = 1.f / (float)(hi - lo);
        const u32x4 xv = *(const u32x4*)(XN + (size_t)row * 1024 + cg8 * 8);
        u32x4 o; o.x = pk2(s[0] * inv - bflo(xv.x), s[1] * inv - bfhi(xv.x)); o.y = pk2(s[2] * inv - bflo(xv.y), s[3] * inv - bfhi(xv.y));
        o.z = pk2(s[4] * inv - bflo(xv.z), s[5] * inv - bfhi(xv.z)); o.w = pk2(s[6] * inv - bflo(xv.w), s[7] * inv - bfhi(xv.w));
        *(u32x4*)(PL + (size_t)row * 1024 + cg8 * 8) = o;
    }
}

constexpr int RC_SQ = 0, RC_SK = 32768, RC_SS = 65536, RC_SKT = 98304, RC_SVT = 131072, RC_SP = 139264;
DI void ret_chain_phase(const Ctx& a, LAS unsigned char* lds) {
    const bf16_t* Q = (const bf16_t*)(a.ws + OFF_RQ); const bf16_t* Kb = (const bf16_t*)(a.ws + OFF_RK);
    const bf16_t* VT = (const bf16_t*)(a.ws + OFF_RVT); const float* dec = (const float*)(a.ws + OFF_DEC);
    const int tid = tid_opaque(), wid = tid >> 6, lane = tid & 63, fr = lane & 15, fq = lane >> 4;
    for (int cid = blockIdx.x; cid < 256; cid += gridDim.x) {
        const int xq = cid & 7, yq = cid >> 3, grp = xq * 4 + (yq >> 3), vs = yq & 7;
        const int dir = grp & 1, h = (grp >> 1) & 3, b = grp >> 3;
        const float lg2 = dec[dir * 4 + h];
        const bf16_t* KT = (const bf16_t*)(a.ws + (dir ? OFF_RKTB : OFF_RKTF));
        bf16_t* O = (bf16_t*)(a.ws + OFF_ACT) + (dir ? (size_t)MT * 2048 : 0);
        f32x4 accS[2][4];
#pragma unroll
        for (int i = 0; i < 2; ++i)
#pragma unroll
            for (int j = 0; j < 4; ++j) accS[i][j] = (f32x4){0.f, 0.f, 0.f, 0.f};
        for (int i = tid; i < 32768 / 16; i += NTHREADS) *(LAS u32x4*)(lds + RC_SS + i * 16) = (u32x4){0u, 0u, 0u, 0u};
        const int it = wid & 3, half = wid >> 2;
        const int icol = 16 * it + fr;
        const float qdec = __builtin_amdgcn_exp2f(lg2 * (float)(dir ? 64 - icol : icol + 1));
        const float cdec = __builtin_amdgcn_exp2f(lg2 * 64.f);
        float wdec[2][4];
#pragma unroll
        for (int j2 = 0; j2 < 2; ++j2)
#pragma unroll
            for (int r = 0; r < 4; ++r) { const int j = 16 * (2 * half + j2) + 4 * fq + r; const int dd = dir ? (j - icol) : (icol - j); const bool keep = dir ? (dd > 0) : (dd >= 0);
                wdec[j2][r] = keep ? __builtin_amdgcn_exp2f(lg2 * (float)dd) : 0.f; }
        __syncthreads();
        u32x4 pkt[4], pvt;
#define RC_ROW0(s_) ((s_) < 4 ? ML + b * 256 + 64 * (dir ? 3 - (s_) : (s_)) : b * 4096 + 64 * (dir ? 67 - (s_) : (s_) - 4))
#define RC_ISSUE(s_) do { const int r0_ = RC_ROW0(s_); \
            _Pragma("unroll") for (int k = 0; k < 4; ++k) { const int p = tid + k * NTHREADS; const int d = p >> 3, ch = p & 7; \
                pkt[k] = *(const u32x4*)(KT + ((size_t)(r0_ >> 6) * 1024 + h * 256 + d) * 64 + ch * 8); } \
            { const int v_ = tid >> 3, ch = tid & 7; pvt = *(const u32x4*)(VT + ((size_t)(r0_ >> 6) * 2048 + h * 512 + vs * 64 + v_) * 64 + ch * 8); } } while (0)
        const int qk_src = ((tid >> 5) * 1024 + h * 256 + (((tid & 31) ^ ((tid >> 5) & 15)) * 8)) * 2;
#define RC_DMA_QK(s_) do { const size_t rb_ = (size_t)RC_ROW0(s_) * 2048 + qk_src; \
            _Pragma("unroll") for (int k = 0; k < 4; ++k) { \
                __builtin_amdgcn_global_load_lds((const unsigned*)((const char*)Q + rb_ + (size_t)k * 16 * 2048), (LAS unsigned*)(lds + RC_SQ + k * 8192 + wid * 1024), 16, 0, 0); \
                __builtin_amdgcn_global_load_lds((const unsigned*)((const char*)Kb + rb_ + (size_t)k * 16 * 2048), (LAS unsigned*)(lds + RC_SK + k * 8192 + wid * 1024), 16, 0, 0); } } while (0)
        RC_ISSUE(0);
        RC_DMA_QK(0);
        for (int s = 0; s < 68; ++s) {
            const int row0 = RC_ROW0(s);
#pragma unroll
            for (int k = 0; k < 4; ++k) { const int p = tid + k * NTHREADS; const int d = p >> 3, ch = p & 7;
                *(LAS u32x4*)(lds + RC_SKT + d * 128 + ((ch ^ ((d >> 1) & 7)) << 4)) = pkt[k]; }
            { const int v_ = tid >> 3, ch = tid & 7;
                *(LAS u32x4*)(lds + RC_SVT + v_ * 128 + ((ch ^ ((v_ >> 1) & 7)) << 4)) = pvt; }
            asm volatile("s_waitcnt vmcnt(0)" ::: "memory");
            if (s + 1 < 68) RC_ISSUE(s + 1);
            LDS_BARRIER();
            int frx = fr; asm volatile("" : "+v"(frx));
            const int sw5 = frx * 512, sw1 = frx * 128, kx = (frx >> 1) & 7;
#define A512(base_, t_, ks_) ((base_) + (t_) * 8192 + sw5 + ((((ks_) * 4 + fq) ^ frx) << 4))
#define A128(base_, t_, k2_) ((base_) + (t_) * 2048 + sw1 + ((((k2_) * 4 + fq) ^ kx) << 4))
            bf16x8 qf[8];
#pragma unroll
            for (int ks = 0; ks < 8; ++ks) qf[ks] = *(const LAS bf16x8*)(lds + A512(RC_SQ, it, ks));
#pragma unroll
            for (int j2 = 0; j2 < 2; ++j2) {
                const int jt = 2 * half + j2;
                f32x4 acc = (f32x4){0.f, 0.f, 0.f, 0.f};
#pragma unroll
                for (int ks = 0; ks < 8; ++ks) { const bf16x8 kf = *(const LAS bf16x8*)(lds + A512(RC_SK, jt, ks)); acc = MFMA16(kf, qf[ks], acc); }
                float pv[4];
#pragma unroll
                for (int r = 0; r < 4; ++r) pv[r] = acc[r] * wdec[j2][r];
                u32x2 w; w.x = pk2(pv[0], pv[1]); w.y = pk2(pv[2], pv[3]);
                *(LAS u32x2*)(lds + RC_SP + icol * 128 + (((2 * jt + (fq >> 1)) ^ ((icol >> 1) & 7)) << 4) + (fq & 1) * 8) = w;
            }
            f32x4 accO[2];
#pragma unroll
            for (int vv = 0; vv < 2; ++vv) {
                f32x4 acc = (f32x4){0.f, 0.f, 0.f, 0.f};
#pragma unroll
                for (int ks = 0; ks < 8; ++ks) { const bf16x8 sf = *(const LAS bf16x8*)(lds + A512(RC_SS, 2 * half + vv, ks)); acc = MFMA16(sf, qf[ks], acc); }
                accO[vv] = acc * qdec;
            }
            LDS_BARRIER();
            if (s + 1 < 68) RC_DMA_QK(s + 1);
#pragma unroll
            for (int vv = 0; vv < 2; ++vv) {
                const int vt = 2 * half + vv;
#pragma unroll
                for (int k2 = 0; k2 < 2; ++k2) {
                    const bf16x8 vf = *(const LAS bf16x8*)(lds + A128(RC_SVT, vt, k2));
                    const bf16x8 pf = *(const LAS bf16x8*)(lds + A128(RC_SP, it, k2));
                    accO[vv] = MFMA16(vf, pf, accO[vv]);
                }
                u32x2 w; w.x = pk2(accO[vv][0], accO[vv][1]); w.y = pk2(accO[vv][2], accO[vv][3]);
                *(u32x2*)(O + (size_t)(row0 + icol) * 2048 + h * 512 + vs * 64 + 16 * vt + 4 * fq) = w;
            }
            bf16x8 vfr[4][2];
#pragma unroll
            for (int vt = 0; vt < 4; ++vt) { vfr[vt][0] = *(const LAS bf16x8*)(lds + A128(RC_SVT, vt, 0)); vfr[vt][1] = *(const LAS bf16x8*)(lds + A128(RC_SVT, vt, 1)); }
#pragma unroll
            for (int di = 0; di < 2; ++di) {
                const int dt = 2 * wid + di;
                bf16x8 kt[2];
#pragma unroll
                for (int k2 = 0; k2 < 2; ++k2) kt[k2] = *(const LAS bf16x8*)(lds + A128(RC_SKT, dt, k2));
#pragma unroll
                for (int vt = 0; vt < 4; ++vt) {
                    f32x4 sacc = accS[di][vt] * cdec;
                    sacc = MFMA16(kt[0], vfr[vt][0], sacc); sacc = MFMA16(kt[1], vfr[vt][1], sacc);
                    accS[di][vt] = sacc;
                    const int v_ = 16 * vt + fr;
                    u32x2 w; w.x = pk2(sacc[0], sacc[1]); w.y = pk2(sacc[2], sacc[3]);
                    *(LAS u32x2*)(lds + RC_SS + v_ * 512 + (((2 * dt + (fq >> 1)) ^ (v_ & 15)) << 4) + (fq & 1) * 8) = w;
                }
            }
            LDS_BARRIER();
        }
    }
}
#undef A512
#undef A128
#undef RC_ISSUE
#undef RC_DMA_QK
#undef RC_ROW0
DI void ret_readout_phase(const Ctx& a) {
    const int tid_ = tid_opaque(); const int lane = tid_ & 63, gw = blockIdx.x * NWAVES + (tid_ >> 6), NGW = gridDim.x * NWAVES;
    const bf16_t* Of = (const bf16_t*)(a.ws + OFF_ACT); const bf16_t* Ob = Of + (size_t)MT * 2048;
    bf16_t* G = (bf16_t*)(a.ws + OFF_RG); const float* gn = a.rgn;
#define RO_OFF(it_) ((size_t)((it_) >> 2) * 2048 + ((it_) & 3) * 512 + 8 * lane)
    const f32x4 gA = *(const f32x4*)(gn + (gw & 3) * 512 + 8 * lane), gB = *(const f32x4*)(gn + (gw & 3) * 512 + 8 * lane + 4);
    u32x4 f1 = {0u, 0u, 0u, 0u}, b1 = f1, g1 = f1, f2 = f1, b2 = f1, g2 = f1;
    if (gw < MT * 4) { const size_t o_ = RO_OFF(gw); f1 = *(const u32x4*)(Of + o_); b1 = *(const u32x4*)(Ob + o_); g1 = *(const u32x4*)(G + o_); }
    if (gw + NGW < MT * 4) { const size_t o_ = RO_OFF(gw + NGW); f2 = *(const u32x4*)(Of + o_); b2 = *(const u32x4*)(Ob + o_); g2 = *(const u32x4*)(G + o_); }
    for (int it = gw; it < MT * 4; it += NGW) {
        const int h = it & 3; const size_t off = RO_OFF(it);
        const u32x4 vf = f1, vb = b1, gv = g1; f1 = f2; b1 = b2; g1 = g2;
        if (it + 2 * NGW < MT * 4) { const size_t o_ = RO_OFF(it + 2 * NGW); f2 = *(const u32x4*)(Of + o_); b2 = *(const u32x4*)(Ob + o_); g2 = *(const u32x4*)(G + o_); }
        float o[8];
        o[0] = bflo(vf.x) + bflo(vb.x); o[1] = bfhi(vf.x) + bfhi(vb.x); o[2] = bflo(vf.y) + bflo(vb.y); o[3] = bfhi(vf.y) + bfhi(vb.y);
        o[4] = bflo(vf.z) + bflo(vb.z); o[5] = bfhi(vf.z) + bfhi(vb.z); o[6] = bflo(vf.w) + bflo(vb.w); o[7] = bfhi(vf.w) + bfhi(vb.w);
        float s = 0.f, s2 = 0.f;
#pragma unroll
        for (int e = 0; e < 8; ++e) { s += o[e]; s2 += o[e] * o[e]; }
        s = row16_sum(s); s2 = row16_sum(s2);
#pragma unroll
        for (int sh_ = 16; sh_ < 64; sh_ <<= 1) { const float a_ = shx(s, sh_, lane), b_ = shx(s2, sh_, lane); s += a_; s2 += b_; }
        const float mu = s * (1.f / 512.f);
        float var = s2 * (1.f / 512.f) - mu * mu; var = var < 0.f ? 0.f : var;
#pragma unroll
        for (int e = 0; e < 8; ++e) o[e] -= mu;
        const float rstd = 1.f / sqrtf(var + 1e-6f);
        u32x4 w;
        w.x = pk2(o[0] * rstd * gA[0] * bflo(gv.x), o[1] * rstd * gA[1] * bfhi(gv.x)); w.y = pk2(o[2] * rstd * gA[2] * bflo(gv.y), o[3] * rstd * gA[3] * bfhi(gv.y));
        w.z = pk2(o[4] * rstd * gB[0] * bflo(gv.z), o[5] * rstd * gB[1] * bfhi(gv.z)); w.w = pk2(o[6] * rstd * gB[2] * bflo(gv.w), o[7] * rstd * gB[3] * bfhi(gv.w));
        *(u32x4*)(G + off) = w;
    }
}

#undef RO_OFF
constexpr int AT_K = 0, AT_V = 24576, AT_BIAS = 49152;
template <bool SWA>
DI void attn_phase(const Ctx& a, LAS unsigned char* lds) {
    const bf16_t* QK = (const bf16_t*)(a.ws + OFF_AQK); const bf16_t* VT = (const bf16_t*)(a.ws + OFF_AVT); bf16_t* O = (bf16_t*)(a.ws + OFF_AO);
    const float* aux = SWA ? a.aux_swa : a.aux_nat;
    const int tid = tid_opaque(); const int lane = tid & 63, fr = lane & 15, fq = lane >> 4, w = tid >> 6;
    constexpr int LDQ = SWA ? 1280 : 2048, HD = SWA ? 256 : 1024, NLAT = 2048, NCTX = 128;
    const int G_ = gridDim.x, vb_ = (G_ % 8 == 0) ? (int)(blockIdx.x % 8) * (G_ / 8) + (int)(blockIdx.x / 8) : (int)blockIdx.x;
    for (int item = vb_; item < NLAT + NCTX; item += G_) {
        int b, kvh, hq, qbase, nloc, loc0 = 0;
        int r = 0, cbk = 0, r0 = 0, cs = 0, rlo = 0, tq0 = 0;
        const bool lat = item < NLAT;
        if (lat) {
            if (!SWA) { const int rp = item & 31; hq = (item >> 5) & 15; b = item >> 9; kvh = hq; r = 2 * rp + (w >> 2); cbk = w & 3; qbase = b * 4096 + r * 64 + 16 * cbk;
                r0 = r - 4 < 0 ? 0 : (r - 4 > 56 ? 56 : r - 4); cs = 16 * cbk - 8 < 0 ? 0 : (16 * cbk - 8 > 32 ? 32 : 16 * cbk - 8);
                rlo = 2 * rp - 4 < 0 ? 0 : (2 * rp - 4 > 56 ? 56 : 2 * rp - 4); const int rh = 2 * rp - 3 < 0 ? 0 : (2 * rp - 3 > 56 ? 56 : 2 * rp - 3);
                nloc = rh + 8 - rlo; loc0 = b * 4096 + rlo * 64; }
            else { const int tb = item & 127; kvh = (item >> 7) & 3; b = item >> 9; hq = kvh * 4 + (w >> 1); tq0 = 32 * tb + 16 * (w & 1); qbase = b * 4096 + tq0;
                int ts = (32 * tb - 128) & ~63; if (ts < 0) ts = 0;
                int te = (32 * tb + 159) >> 6; if (te > 63) te = 63;
                nloc = te - (ts >> 6) + 1; loc0 = b * 4096 + ts; rlo = ts; }
        } else {
            const int i2 = item - NLAT;
            if (!SWA) { const int hf = i2 & 1; hq = (i2 >> 1) & 15; b = i2 >> 5; kvh = hq; qbase = ML + b * 256 + 128 * hf + 16 * w; }
            else { const int q8 = i2 & 7; kvh = (i2 >> 3) & 3; b = i2 >> 5; hq = kvh * 4 + (w >> 1); qbase = ML + b * 256 + 32 * q8 + 16 * (w & 1); }
            nloc = 0;
        }
        const int koff = 1024 + kvh * 64, ntile = nloc + 4;
        int nb_off[8]; float nb_mask[8];
        if (!SWA) {
#pragma unroll
            for (int e = 0; e < 8; ++e) { const int col = cs + 16 * (e >> 2) + 4 * fq + (e & 3), ci = 16 * cbk + fr; const int c0 = ci - 8 < 0 ? 0 : (ci - 8 > 48 ? 48 : ci - 8);
                int bi = col - ci + 15; bi = bi < 0 ? 0 : (bi > 30 ? 30 : bi); nb_off[e] = AT_BIAS + 4 * bi; nb_mask[e] = ((col >= c0) && (col <= c0 + 15)) ? 0.f : -1e30f; }
        }
        bf16x8 qf[2];
#pragma unroll
        for (int ks = 0; ks < 2; ++ks) qf[ks] = *(const bf16x8*)(QK + (size_t)(qbase + fr) * LDQ + hq * 64 + 32 * ks + 8 * fq);
        float m_run = SWA ? aux[hq] : -1e30f, l_run = (SWA && fq == 0) ? 1.f : 0.f;
        f32x4 o[4];
#pragma unroll
        for (int dt = 0; dt < 4; ++dt) o[dt] = (f32x4){0.f, 0.f, 0.f, 0.f};
        const int srow = tid >> 3, sch = (tid & 7) ^ ((srow >> 1) & 7);
#define AT_TBASE(ti_) ((ti_) >= 4 ? loc0 + 64 * ((ti_) - 4) : ML + b * 256 + 64 * (ti_))
#define AT_DMA(ti_, bf_) do { const int kb_ = AT_TBASE(ti_); \
            __builtin_amdgcn_global_load_lds((const unsigned*)(QK + (size_t)(kb_ + srow) * LDQ + koff + sch * 8), (LAS unsigned*)(lds + AT_K + (bf_) * 8192 + w * 1024), 16, 0, 0); \
            __builtin_amdgcn_global_load_lds((const unsigned*)(VT + ((size_t)(kb_ >> 6) * HD + kvh * 64 + srow) * 64 + sch * 8), (LAS unsigned*)(lds + AT_V + (bf_) * 8192 + w * 1024), 16, 0, 0); } while (0)
        LDS_BARRIER();
        float bias_v = 0.f;
        if (!SWA) { if (tid < 15 * 31) bias_v = aux[hq * 465 + tid]; }
        AT_DMA(0, 0); AT_DMA(1, 1);
        if (!SWA) { if (tid < 15 * 31) ((LAS float*)(lds + AT_BIAS))[tid] = bias_v; }
        asm volatile("" :: "v"(qf[0]), "v"(qf[1]), "v"(m_run));
        asm volatile("s_waitcnt vmcnt(2)" ::: "memory");
        LDS_BARRIER();
        int buf = 0;
        for (int ti = 0; ti < ntile; ++ti) {
            const bool local = ti >= 4; const int tl = ti - 4;
            int nck = 2, k0off = 0, brow = 0;
            float bias[8];
            if (local) {
                if (!SWA) { const int gr = rlo + tl; nck = (gr >= r0 && gr <= r0 + 7) ? 1 : 0; k0off = cs; brow = gr - r + 7; brow = brow < 0 ? 0 : (brow > 14 ? 14 : brow);
#pragma unroll
                    for (int e = 0; e < 8; ++e) bias[e] = *(const LAS float*)(lds + nb_off[e] + brow * 124) + nb_mask[e]; }
            }
            { const int b2 = buf + 2 >= 3 ? buf - 1 : buf + 2; if (ti + 2 < ntile) AT_DMA(ti + 2, b2); }
            if (nck == 2) {
                const int tkey0 = rlo + 64 * tl;
                f32x4 sc[4];
#pragma unroll
                for (int jt = 0; jt < 4; ++jt) {
                    const int row = 16 * jt + fr; const int sw = (row >> 1) & 7;
                    const bf16x8 k0 = *(const LAS bf16x8*)(lds + AT_K + buf * 8192 + row * 128 + ((fq ^ sw) << 4));
                    const bf16x8 k1 = *(const LAS bf16x8*)(lds + AT_K + buf * 8192 + row * 128 + (((4 + fq) ^ sw) << 4));
                    f32x4 acc = (f32x4){0.f, 0.f, 0.f, 0.f}; acc = MFMA16(k0, qf[0], acc); acc = MFMA16(k1, qf[1], acc); sc[jt] = acc;
                }
                float sv[16]; bool ok[16];
#pragma unroll
                for (int jt = 0; jt < 4; ++jt)
#pragma unroll
                    for (int rr = 0; rr < 4; ++rr) {
                        bool valid = true;
                        if (SWA && local) { const int dd = tkey0 + 16 * jt + 4 * fq + rr - (tq0 + fr); valid = (dd <= 128) && (dd >= -128); }
                        sv[jt * 4 + rr] = valid ? sc[jt][rr] : -1e30f; ok[jt * 4 + rr] = valid;
                    }
                float cmax = sv[0];
#pragma unroll
                for (int e = 1; e < 16; ++e) cmax = fmaxf(cmax, sv[e]);
                cmax = fmaxf(cmax, shx(cmax, 16, lane)); cmax = fmaxf(cmax, shx(cmax, 32, lane));
                const float m_new = fmaxf(m_run, cmax);
                const float alpha = __builtin_amdgcn_exp2f((m_run - m_new) * LOG2E);
                float p[16], psum = 0.f;
#pragma unroll
                for (int e = 0; e < 16; ++e) { p[e] = ok[e] ? __builtin_amdgcn_exp2f((sv[e] - m_new) * LOG2E) : 0.f; psum += p[e]; }
                l_run = l_run * alpha + psum; m_run = m_new;
                u32x4 pw0, pw1; pw0.x = pk2(p[0], p[1]); pw0.y = pk2(p[2], p[3]); pw0.z = pk2(p[4], p[5]); pw0.w = pk2(p[6], p[7]);
                pw1.x = pk2(p[8], p[9]); pw1.y = pk2(p[10], p[11]); pw1.z = pk2(p[12], p[13]); pw1.w = pk2(p[14], p[15]);
                const bf16x8 pf0 = __builtin_bit_cast(bf16x8, pw0), pf1 = __builtin_bit_cast(bf16x8, pw1);
                if (__builtin_amdgcn_ballot_w64(alpha != 1.f) != 0ull) {
#pragma unroll
                    for (int dt = 0; dt < 4; ++dt) o[dt] = o[dt] * alpha;
                }
                const int kc = (fq >> 1), kb8 = (fq & 1) * 8;
#pragma unroll
                for (int dt = 0; dt < 4; ++dt) {
                    const int d = 16 * dt + fr, sw = (d >> 1) & 7; const int vb = AT_V + buf * 8192 + d * 128 + kb8;
                    const s16x4 v0 = *(const LAS s16x4*)(lds + vb + ((kc ^ sw) << 4)), v1 = *(const LAS s16x4*)(lds + vb + (((kc + 2) ^ sw) << 4));
                    const s16x4 v2 = *(const LAS s16x4*)(lds + vb + (((kc + 4) ^ sw) << 4)), v3 = *(const LAS s16x4*)(lds + vb + (((kc + 6) ^ sw) << 4));
                    o[dt] = MFMA16(__builtin_shufflevector(v0, v1, 0, 1, 2, 3, 4, 5, 6, 7), pf0, o[dt]);
                    o[dt] = MFMA16(__builtin_shufflevector(v2, v3, 0, 1, 2, 3, 4, 5, 6, 7), pf1, o[dt]);
                }
            } else
            for (int ck = 0; ck < nck; ++ck) {
                const int ko = k0off + 32 * ck;
                int tkey0 = 0;
                if (SWA && local) { tkey0 = rlo + 64 * tl + ko; if (tkey0 + 31 < tq0 - 128 || tkey0 > tq0 + 15 + 128) continue; }
                f32x4 sc[2];
#pragma unroll
                for (int jt = 0; jt < 2; ++jt) {
                    const int row = ko + 16 * jt + fr; const int sw = (row >> 1) & 7;
                    const bf16x8 k0 = *(const LAS bf16x8*)(lds + AT_K + buf * 8192 + row * 128 + ((fq ^ sw) << 4));
                    const bf16x8 k1 = *(const LAS bf16x8*)(lds + AT_K + buf * 8192 + row * 128 + (((4 + fq) ^ sw) << 4));
                    f32x4 acc = (f32x4){0.f, 0.f, 0.f, 0.f}; acc = MFMA16(k0, qf[0], acc); acc = MFMA16(k1, qf[1], acc); sc[jt] = acc;
                }
                float sv[8]; bool ok[8];
#pragma unroll
                for (int jt = 0; jt < 2; ++jt)
#pragma unroll
                    for (int rr = 0; rr < 4; ++rr) {
                        const int jj = 16 * jt + 4 * fq + rr; float x = sc[jt][rr]; bool valid = true;
                        if (local) {
                            if (!SWA) { x += bias[jt * 4 + rr]; }
                            else { const int dd = tkey0 + jj - (tq0 + fr); valid = (dd <= 128) && (dd >= -128); }
                        }
                        sv[jt * 4 + rr] = valid ? x : -1e30f; ok[jt * 4 + rr] = valid;
                    }
                float cmax = sv[0];
#pragma unroll
                for (int e = 1; e < 8; ++e) cmax = fmaxf(cmax, sv[e]);
                cmax = fmaxf(cmax, shx(cmax, 16, lane)); cmax = fmaxf(cmax, shx(cmax, 32, lane));
                const float m_new = fmaxf(m_run, cmax);
                const float alpha = __builtin_amdgcn_exp2f((m_run - m_new) * LOG2E);
                float p[8], psum = 0.f;
#pragma unroll
                for (int e = 0; e < 8; ++e) { p[e] = ok[e] ? __builtin_amdgcn_exp2f((sv[e] - m_new) * LOG2E) : 0.f; psum += p[e]; }
                l_run = l_run * alpha + psum; m_run = m_new;
                u32x4 pw; pw.x = pk2(p[0], p[1]); pw.y = pk2(p[2], p[3]); pw.z = pk2(p[4], p[5]); pw.w = pk2(p[6], p[7]);
                const bf16x8 pf = __builtin_bit_cast(bf16x8, pw);
                if (__builtin_amdgcn_ballot_w64(alpha != 1.f) != 0ull) {
#pragma unroll
                    for (int dt = 0; dt < 4; ++dt) o[dt] = o[dt] * alpha;
                }
                const int kc = (ko >> 3) + (fq >> 1), kb8 = (fq & 1) * 8;
#pragma unroll
                for (int dt = 0; dt < 4; ++dt) {
                    const int d = 16 * dt + fr, sw = (d >> 1) & 7;
                    const s16x4 v0 = *(const LAS s16x4*)(lds + AT_V + buf * 8192 + d * 128 + ((kc ^ sw) << 4) + kb8);
                    const s16x4 v1 = *(const LAS s16x4*)(lds + AT_V + buf * 8192 + d * 128 + (((kc + 2) ^ sw) << 4) + kb8);
                    const bf16x8 vfr = __builtin_shufflevector(v0, v1, 0, 1, 2, 3, 4, 5, 6, 7);
                    o[dt] = MFMA16(vfr, pf, o[dt]);
                }
            }
            if (ti + 2 < ntile) asm volatile("s_waitcnt vmcnt(2)" ::: "memory"); else asm volatile("s_waitcnt vmcnt(0)" ::: "memory");
            LDS_BARRIER();
            buf = buf == 2 ? 0 : buf + 1;
        }
        float l_tot = l_run; l_tot += shx(l_tot, 16, lane); l_tot += shx(l_tot, 32, lane);
        const float inv = 1.f / l_tot;
#pragma unroll
        for (int dt = 0; dt < 4; ++dt) { u32x2 wv; wv.x = pk2(o[dt][0] * inv, o[dt][1] * inv); wv.y = pk2(o[dt][2] * inv, o[dt][3] * inv);
            *(u32x2*)(O + (size_t)(qbase + fr) * 1024 + hq * 64 + 16 * dt + 4 * fq) = wv; }
    }
#undef AT_DMA
#undef AT_TBASE
}

#define XB_TMO      128
#define XB_XCNT(j)  (256  + 64 * (j))
#define XB_XSUB(j)  (1280 + 64 * (j))
#define XB_XGEN(j)  (2304 + 64 * (j))
#define XB_TOP      3328
#define XB_TOPGEN   3392
#define XCD_BAR_WORDS 3456
#define XB_SPIN_CAP (1u << 18)

__device__ __forceinline__ unsigned xb_ld(unsigned* p)              { return __hip_atomic_load(p, __ATOMIC_RELAXED, __HIP_MEMORY_SCOPE_AGENT); }
__device__ __forceinline__ unsigned xb_add(unsigned* p, unsigned v) { return __hip_atomic_fetch_add(p, v, __ATOMIC_RELAXED, __HIP_MEMORY_SCOPE_AGENT); }
__device__ __forceinline__ unsigned xb_xcc_id() { return (unsigned)__builtin_amdgcn_s_getreg((3 << 11) | 20) & 0xFu; }
#define XB_SPIN(cond, bar) do { unsigned _sp = 0; while (cond) { __builtin_amdgcn_s_sleep(1); \
    if ((++_sp & 255u) == 0u) { if (xb_ld(&(bar)[XB_TMO])) break; if (_sp > XB_SPIN_CAP) { atomicAdd(&(bar)[XB_TMO], 1u); break; } } } } while (0)

struct XcdBarrier {
    unsigned* bar; unsigned x;
    volatile LAS unsigned* st;
};

__device__ __forceinline__ XcdBarrier xcd_barrier_post(unsigned* bar, volatile LAS unsigned* st) {
    XcdBarrier b; b.bar = bar; b.x = xb_xcc_id(); b.st = st;
    if (threadIdx.x == 0) (void)xb_add(&bar[XB_XCNT(b.x)], 1u);
    return b;
}
__device__ __forceinline__ void xcd_barrier_complete(unsigned* bar, unsigned x, unsigned& nloc, unsigned& nx) {
    const unsigned G = gridDim.x * gridDim.y * gridDim.z;
    unsigned sum, cnt, mine, sp = 0u;
    for (;;) {
        sum = 0u; cnt = 0u; mine = 0u;
#pragma unroll
        for (unsigned j = 0; j < 16; ++j) { const unsigned c = xb_ld(&bar[XB_XCNT(j)]); sum += c; cnt += (c > 0u) ? 1u : 0u; mine = (j == x) ? c : mine; }
        if (sum == G) break;
        __builtin_amdgcn_s_sleep(1);
        if ((++sp & 255u) == 0u) { if (xb_ld(&bar[XB_TMO])) break; if (sp > XB_SPIN_CAP) { atomicAdd(&bar[XB_TMO], 1u); break; } }
    }
    nloc = mine > 0u ? mine : 1u; nx = cnt > 0u ? cnt : 1u;
}

__device__ __forceinline__ void xcd_barrier(const XcdBarrier& b) {
    asm volatile("s_waitcnt vmcnt(0)" ::: "memory");
    __syncthreads();
    if (threadIdx.x == 0) {
        unsigned* bar = b.bar;
        __builtin_amdgcn_s_waitcnt(0);
        unsigned nloc = b.st[0], nx = b.st[1];
        if (nloc == 0u) { xcd_barrier_complete(bar, b.x, nloc, nx); b.st[0] = nloc; b.st[1] = nx; }
        const unsigned old = xb_add(&bar[XB_XSUB(b.x)], 1u);
        const unsigned gen = old / nloc;
        if (old + 1u == (gen + 1u) * nloc) {
            __builtin_amdgcn_fence(__ATOMIC_RELEASE, "agent");
            asm volatile("s_waitcnt vmcnt(0)" ::: "memory");
            const unsigned og = xb_add(&bar[XB_TOP], 1u);
            const unsigned tg = og / nx;
            if (og + 1u == (tg + 1u) * nx) xb_add(&bar[XB_TOPGEN], 1u);
            else XB_SPIN(xb_ld(&bar[XB_TOPGEN]) == tg, bar);
            __builtin_amdgcn_fence(__ATOMIC_ACQUIRE, "agent");
            xb_add(&bar[XB_XGEN(b.x)], 1u);
            asm volatile("s_waitcnt vmcnt(0)" ::: "memory");
        } else {
            XB_SPIN(xb_ld(&bar[XB_XGEN(b.x)]) == gen, bar);
            __builtin_amdgcn_fence(__ATOMIC_ACQUIRE, "agent");
            asm volatile("s_waitcnt vmcnt(0)" ::: "memory");
        }
    }
    __syncthreads();
}

constexpr int N_PHASES = 46;
__host__ __device__ inline bool phase_empty(int ph) {
    if (ph == 0 || ph == 45) return false;
    const int l = (ph - 1) / 11, k = (ph - 1) % 11;
    if (k == 6 && l != 0) return true;
    if (k == 5 && l == 2) return true;
    return false;
}

__global__ void __launch_bounds__(NTHREADS) mega(Args a) {
    extern __shared__ __attribute__((aligned(16))) unsigned char lds_raw[];
    LAS unsigned char* lds = (LAS unsigned char*)lds_raw;
#if !MK_MULTI
    volatile LAS unsigned* bst = (volatile LAS unsigned*)(lds + LDS_PHASE_BYTES);
    if (threadIdx.x < 2) bst[threadIdx.x] = 0u;
    __syncthreads();
    const XcdBarrier xbar = xcd_barrier_post((unsigned*)(a.ws + OFF_BAR), bst);
#endif
    for (int ph = a.ph_lo; ph < a.ph_hi; ++ph) {
        if (phase_empty(ph)) continue;
        size_t zoff_ = 0; asm volatile("" : "+s"(zoff_));
        unsigned char* ws = a.ws + zoff_;
        int G = gridDim.x, bid = blockIdx.x; asm volatile("" : "+s"(G), "+s"(bid));
        const Ctx al{ws, a.out, a.in[I_NORMG], a.in[I_FNG], a.in[I_RGN], a.in[I_NRPB], a.in[I_SSINK], a.in[I_PSC], a.in[I_X], a.in[I_CTX]};
        const float* mod = (const float*)(ws + OFF_MOD);
        int dupbit = 0;
        if (ph == 0) dupbit = 1; else if (ph != 45) { const int l_ = (ph - 1) / 11, k_ = (ph - 1) % 11;
            if (k_ == 0 || k_ == 3 || k_ == 8) dupbit = 2; else if (k_ == 1 || k_ == 9) dupbit = 4; else if (k_ == 4) dupbit = 8 << l_; else if (k_ == 5) dupbit = 128 << l_; else if (k_ == 6) dupbit = 2048; else if (k_ == 2 || k_ == 7 || k_ == 10) dupbit = 4096; }
        const int nrep = (MK_DUP & dupbit) ? 2 : 1;
        for (int rep = 0; rep < nrep; ++rep) {
        if (ph == 0) { if (MK_MASK & 1) prologue(a, lds); }
        else if (ph == 45) { if (MK_MASK & 2) final_phase(al); }
        else {
            const int l = (ph - 1) / 11, k = (ph - 1) % 11;
            if (k == 0 || k == 3 || k == 8) { if (MK_MASK & 2) { const int nslm = l == 0 ? 8 : (l == 2 ? 1 : 4);
                    norm_phase(al, l, k == 0 ? 0 : (k == 3 ? 1 : 2), ph == 1, (const float*)(ws + (k == 8 ? OFF_ACT : OFF_MIX)), k == 8 ? nslm : 11, (l == 3 && k == 8) ? ML : MT); } }
            else if (k == 1 || k == 9) {
                const int s = k == 1 ? 0 : 1;
                pg8::Gemm g{(const bf16_t*)(ws + OFF_XN), (const bf16_t*)(ws + OFF_WFI) + (size_t)(l * 2 + s) * 5632 * 1024, 1024, 1024, 1024, (l == 3 && k == 9) ? 64 : MT / 256, 22, 0, nullptr, nullptr};
                pg8::StaticOrder S; S.init(g.nM, g.nN, G, bid, g.K);
                EpiSwiglu E{(bf16_t*)(ws + OFF_ACT)};
                if (MK_MASK & 4) pg8::gemm_phase(lds, g, S, E);
            } else if (k == 2 || k == 10 || k == 7) {
                const bf16_t* gA; const bf16_t* gB; int lda, ldb, K_, apo = 0; const float* csc = nullptr; const float* gate; float w_;
                if (k != 7) {
                    const int s = k == 2 ? 0 : 1;
                    gA = (const bf16_t*)(ws + OFF_ACT); gB = (const bf16_t*)(ws + OFF_WFO) + (size_t)(l * 2 + s) * 1024 * 2816; lda = 2816; ldb = 2816; K_ = 2816;
                    gate = mod + (size_t)l * 5 * MODW + ((k == 2 ? 0 : 2) * 3 + 2) * 1024; w_ = 0.5f;
                } else {
                    gate = mod + (size_t)l * 5 * MODW + (1 * 3 + 2) * 1024; w_ = 1.f;
                    if (l == 0) { gA = (const bf16_t*)(ws + OFF_RG); gB = (const bf16_t*)(ws + OFF_WRO); lda = 2048; ldb = 2048; K_ = 2048; }
                    else if (l == 1) { gA = (const bf16_t*)(ws + OFF_AO); gB = (const bf16_t*)(ws + OFF_WNO); lda = 1024; ldb = 1024; K_ = 1024; }
                    else if (l == 2) { gA = (const bf16_t*)(ws + OFF_PL); gB = (const bf16_t*)(ws + OFF_WPL); lda = 1024; ldb = 256; K_ = 256; apo = 256; csc = al.psc; }
                    else { gA = (const bf16_t*)(ws + OFF_AO); gB = (const bf16_t*)(ws + OFF_WSO); lda = 1024; ldb = 1024; K_ = 1024; }
                }
                const pg8::Gemm g{gA, gB, lda, ldb, K_, 64, 4, apo, nullptr, nullptr};
                const EpiResid E{(float*)(ws + OFF_H), (l == 0 && k == 2) ? al.x : (const float*)(ws + OFF_H), gate, csc, (float*)(ws + (k == 7 ? OFF_ACT : OFF_MIX)), (nrep == 2 && rep == 0) ? 0.f : w_, 0.f};
                pg8::StaticOrder S; S.init(64, 4, G, bid, K_, (l == 3 && k >= 7) ? 0 : 4);
                if (MK_MASK & 8) pg8::gemm_phase(lds, g, S, E);
            } else if (k == 4) {
                const bf16_t* XN = (const bf16_t*)(ws + OFF_XN);
                if (l == 0) {
                    pg8::Gemm g{XN, (const bf16_t*)(ws + OFF_WRI), 1024, 1024, 1024, MT / 256, 16, 0, (const bf16_t*)(ws + OFF_WRI) + (size_t)3072 * 1024, XN};
                    pg8::StaticOrder S; S.init(MT / 256, 16, G, bid, 1024, 0, 12, MT / 256);
                    EpiDual<EpiRetNat, EpiRetSwp> E{EpiRetNat{(bf16_t*)(ws + OFF_RG), (bf16_t*)(ws + OFF_RQ), (bf16_t*)(ws + OFF_RK), (const f32x2*)(ws + OFF_CS)},
                                                    EpiRetSwp{(bf16_t*)(ws + OFF_RKTF), (bf16_t*)(ws + OFF_RKTB), (bf16_t*)(ws + OFF_RVT), (const f32x2*)(ws + OFF_CST), (const float*)(ws + OFF_DEC)}};
                    if (MK_MASK & 16) pg8::gemm_phase(lds, g, S, E);
                } else if (l == 2) {
                    if (MK_MASK & 2) pool_phase(al);
                } else if (l == 1) {
                    pg8::Gemm g{XN, (const bf16_t*)(ws + OFF_WNQ), 1024, 1024, 1024, MT / 256, 8, 0, (const bf16_t*)(ws + OFF_WNQ) + (size_t)2048 * 1024, XN};
                    pg8::StaticOrder S; S.init(MT / 256, 8, G, bid, 1024, 0, 4, MT / 256);
                    EpiDual<EpiBf16, EpiBf16> E{EpiBf16{(bf16_t*)(ws + OFF_AQK), 2048, 4, 0.125f, 0, 0}, EpiBf16{(bf16_t*)(ws + OFF_AVT), MT, 0, 1.f, 1024, 0}};
                    if (MK_MASK & 64) pg8::gemm_phase(lds, g, S, E);
                } else {
                    pg8::Gemm g{XN, (const bf16_t*)(ws + OFF_WSQ), 1024, 1024, 1024, MT / 256, 5, 0, (const bf16_t*)(ws + OFF_WSQ) + (size_t)1280 * 1024, XN};
                    pg8::StaticOrder S; S.init(MT / 256, 5, G, bid, 1024, 0, 1, MT / 256);
                    EpiDual<EpiSwaNat, EpiBf16> E{EpiSwaNat{(bf16_t*)(ws + OFF_AQK), (const f32x2*)(ws + OFF_CS2)}, EpiBf16{(bf16_t*)(ws + OFF_AVT), MT, 0, 1.f, 256, 0}};
                    if (MK_MASK & 128) pg8::gemm_phase(lds, g, S, E);
                }
            } else if (k == 5) {
                if (l == 0) { if (MK_MASK & 512) ret_chain_phase(al, lds); }
                else if (l == 1) { if (MK_MASK & 1024) attn_phase<false>(al, lds); }
                else if (l == 3) { if (MK_MASK & 2048) attn_phase<true>(al, lds); }
            } else if (k == 6) {
                if (MK_MASK & 2) ret_readout_phase(al);
            }
        }
        }
#if !MK_MULTI
        if (ph + 1 < a.ph_hi) { if (ph == 0) cg::this_grid().sync(); else xcd_barrier(xbar); }
#endif
    }
}

extern "C" void kernel_launch(void* const* d_in, const int* in_sizes, int n_in, void* d_out, int out_size, void* d_ws, size_t ws_size, hipStream_t stream) {
    static int grid = 0;
    if (grid == 0) {
        if (n_in != 23 || ws_size < WS_END) { fprintf(stderr, "kernel_launch: need 23 inputs and %zu bytes of workspace (got %d, %zu)\n", (size_t)WS_END, n_in, ws_size); grid = -1; return; }
        int dev = 0, cus = 0, per_cu = 0;
        hipGetDevice(&dev); hipDeviceGetAttribute(&cus, hipDeviceAttributeMultiprocessorCount, dev);
        if (hipFuncSetAttribute((const void*)mega, hipFuncAttributeMaxDynamicSharedMemorySize, LDS_BYTES) != hipSuccess) { fprintf(stderr, "kernel_launch: hipFuncSetAttribute failed\n"); grid = -1; return; }
        if (hipOccupancyMaxActiveBlocksPerMultiprocessor(&per_cu, (const void*)mega, NTHREADS, LDS_BYTES) != hipSuccess || per_cu < 1) { fprintf(stderr, "kernel_launch: occupancy query gives %d\n", per_cu); per_cu = 1; }
        (void)hipGetLastError();
        grid = cus * 1;
        if (grid > 256) grid = 256;
    }
    if (grid < 0) return;
    Args a{};
    for (int i = 0; i < 23; ++i) a.in[i] = (const float*)d_in[i];
    a.out = (float*)d_out; a.ws = (unsigned char*)d_ws;
#if MK_MULTI
    for (int ph = 0; ph < N_PHASES; ++ph) {
        if (phase_empty(ph)) continue;
        a.ph_lo = ph; a.ph_hi = ph + 1;
        hipLaunchKernelGGL(mega, dim3(grid), dim3(NTHREADS), LDS_BYTES, stream, a);
    }
#else
    a.ph_lo = 0; a.ph_hi = N_PHASES;
    if (hipMemsetAsync((char*)d_ws, 0, OFF_BAR + 16384, stream) != hipSuccess) { fprintf(stderr, "kernel_launch: memset of barrier words failed\n"); return; }
    void* args[] = {&a};
    hipError_t e = hipLaunchCooperativeKernel((const void*)mega, dim3(grid), dim3(NTHREADS), args, LDS_BYTES, stream);
    if (e != hipSuccess) fprintf(stderr, "cooperative launch failed: %s (grid %d)\n", hipGetErrorString(e), grid);
#endif
}
```

```cpp
#include <hip/hip_runtime.h>
#include <hip/hip_cooperative_groups.h>
#include <cstdio>
#include <cstdint>
namespace cg = cooperative_groups;

#ifndef MK_MASK
#define MK_MASK 0xFFFF
#endif
#ifndef MK_DUP
#define MK_DUP 0
#endif
#ifndef MK_MULTI
#define MK_MULTI 0
#endif

#define LAS __attribute__((address_space(3)))
typedef unsigned short bf16_t;
typedef short bf16x8 __attribute__((ext_vector_type(8)));
typedef short s16x4 __attribute__((ext_vector_type(4)));
typedef float f32x4 __attribute__((ext_vector_type(4)));
typedef float f32x2 __attribute__((ext_vector_type(2)));
typedef unsigned u32x4 __attribute__((ext_vector_type(4)));
typedef unsigned u32x2 __attribute__((ext_vector_type(2)));
#define DI __device__ __forceinline__

constexpr int D = 1024, NB = 4, SEQ = 4096, CTXL = 256, FF = 2816;
constexpr int ML = NB * SEQ;
constexpr int MC = NB * CTXL;
constexpr int MT = ML + MC;
constexpr int MODW = 9 * D;
constexpr float LOG2E = 1.4426950408889634f;
constexpr int NTHREADS = 512, NWAVES = 8;
constexpr int LDS_PHASE_BYTES = 147456, LDS_BYTES = LDS_PHASE_BYTES + 64;

constexpr size_t al256(size_t x) { return (x + 255) & ~(size_t)255; }
constexpr size_t OFF_MOD = 0;
constexpr size_t OFF_PTAB = al256(OFF_MOD + (size_t)4 * 5 * MODW * 4);
constexpr size_t OFF_BAR = al256(OFF_PTAB + 256);
constexpr size_t OFF_DEC = al256(OFF_BAR + 16384);
constexpr size_t OFF_CS2 = al256(OFF_DEC + 64);
constexpr size_t OFF_CS = al256(OFF_CS2 + 64 * 16 * 8);
constexpr size_t OFF_CST = al256(OFF_CS + (size_t)4096 * 128 * 8);
constexpr size_t OFF_WFI = al256(OFF_CST + (size_t)4096 * 128 * 8);
constexpr size_t OFF_WFO = al256(OFF_WFI + (size_t)8 * 5632 * 1024 * 2);
constexpr size_t OFF_WRI = al256(OFF_WFO + (size_t)8 * 1024 * 2816 * 2);
constexpr size_t OFF_WRO = al256(OFF_WRI + (size_t)6144 * 1024 * 2);
constexpr size_t OFF_WNQ = al256(OFF_WRO + (size_t)1024 * 2048 * 2);
constexpr size_t OFF_WNO = al256(OFF_WNQ + (size_t)3072 * 1024 * 2);
constexpr size_t OFF_WPL = al256(OFF_WNO + (size_t)1024 * 1024 * 2);
constexpr size_t OFF_WSQ = al256(OFF_WPL + (size_t)4 * 256 * 256 * 2);
constexpr size_t OFF_WSO = al256(OFF_WSQ + (size_t)1536 * 1024 * 2);
constexpr size_t OFF_H = al256(OFF_WSO + (size_t)1024 * 1024 * 2);
constexpr size_t OFF_XN = al256(OFF_H + (size_t)MT * 1024 * 4);
constexpr size_t OFF_ACT = al256(OFF_XN + (size_t)MT * 1024 * 2);
constexpr size_t ACT_BYTES = (size_t)2 * MT * 2048 * 2;
constexpr size_t OFF_MIX = al256(OFF_ACT + ACT_BYTES);
constexpr size_t OFF_RG = OFF_MIX;
constexpr size_t OFF_RQ = OFF_RG + (size_t)MT * 2048 * 2;
constexpr size_t OFF_RK = OFF_RQ + (size_t)MT * 1024 * 2;
constexpr size_t OFF_RKTF = OFF_RK + (size_t)MT * 1024 * 2;
constexpr size_t OFF_RKTB = OFF_RKTF + (size_t)MT * 1024 * 2;
constexpr size_t OFF_RVT = OFF_RKTB + (size_t)MT * 1024 * 2;
constexpr size_t WS_END = OFF_RVT + (size_t)MT * 2048 * 2;
constexpr size_t OFF_AQK = OFF_MIX;
constexpr size_t OFF_AVT = OFF_AQK + (size_t)MT * 2048 * 2;
constexpr size_t OFF_AO = OFF_AVT + (size_t)MT * 1024 * 2;
constexpr size_t OFF_PL = OFF_MIX;

DI unsigned f2bf(float f) { unsigned u = __builtin_bit_cast(unsigned, f); return (u + 0x7fffu + ((u >> 16) & 1u)) >> 16; }
typedef __bf16 hbf16x2 __attribute__((ext_vector_type(2)));
DI unsigned pk2(float lo, float hi) { const f32x2 v = {lo, hi}; const hbf16x2 b = __builtin_convertvector(v, hbf16x2); return __builtin_bit_cast(unsigned, b); }
DI float bflo(unsigned u) { return __builtin_bit_cast(float, u << 16); }
DI float bfhi(unsigned u) { return __builtin_bit_cast(float, u & 0xffff0000u); }
DI float silu_f(float a) { return a * __builtin_amdgcn_rcpf(1.f + __builtin_amdgcn_exp2f(-a * LOG2E)); }
#define LDS_BARRIER() do { asm volatile("s_waitcnt lgkmcnt(0)" ::: "memory"); __builtin_amdgcn_s_barrier(); } while (0)
DI int tid_opaque() { int t = threadIdx.x; asm volatile("" : "+v"(t)); return t; }
DI float shx(float v, int m, int lane) { return __builtin_bit_cast(float, __builtin_amdgcn_ds_bpermute((lane ^ m) << 2, __builtin_bit_cast(int, v))); }
DI float dpp_f(float v, const int ctrl_sel) {
    const int x = __builtin_bit_cast(int, v); int r;
    if (ctrl_sel == 0) r = __builtin_amdgcn_update_dpp(x, x, 0xB1, 0xF, 0xF, false);
    else if (ctrl_sel == 1) r = __builtin_amdgcn_update_dpp(x, x, 0x4E, 0xF, 0xF, false);
    else if (ctrl_sel == 2) r = __builtin_amdgcn_update_dpp(x, x, 0x124, 0xF, 0xF, false);
    else r = __builtin_amdgcn_update_dpp(x, x, 0x128, 0xF, 0xF, false);
    return __builtin_bit_cast(float, r);
}
DI float row16_sum(float v) { v += dpp_f(v, 0); v += dpp_f(v, 1); v += dpp_f(v, 2); v += dpp_f(v, 3); return v; }
DI float wave_sum(float v, int lane) {
    v = row16_sum(v);
    v += shx(v, 16, lane); v += shx(v, 32, lane);
    return v;
}
#define MFMA16(a, b, c) __builtin_amdgcn_mfma_f32_16x16x32_bf16((a), (b), (c), 0, 0, 0)

namespace pg8 {
constexpr int BM = 256, BK = 64, HALF = 128, HTB = HALF * BK * 2, STAGE_BYTES = 8 * HTB, NXCD = 8, WGM = 8;
DI int lds_byte(int r, int c) { const int st = (r >> 4) * 2 + (c >> 5), rr = r & 15, cc = c & 31, ob = rr * 64 + cc * 2; return st * 1024 + (ob ^ (((ob >> 9) & 1) << 5)); }
DI void stage_rc(int b, int& R, int& C) { const int st = b / 1024, sb = b % 1024, swz = sb ^ (((sb >> 9) & 1) << 5); R = (st >> 1) * 16 + swz / 64; C = (st & 1) * 32 + (swz % 64) / 2; }
DI int perm32(int rho) { const int n = rho >> 4, i = rho & 15; return 8 * (i >> 2) + 4 * n + (i & 3); }
struct Unit { int pm, pn, k0, nt, kind; };
struct Gemm { const bf16_t* A; const bf16_t* Bt; int lda, ldb, K, nM, nN, a_pn_off; const bf16_t* A2; const bf16_t* Bt2; };
struct StaticOrder {
    int nM, nN, nwg, G, c, ntK, nsl, nsplit, nM2, nN2, nwg2;
    DI void init(int nM_, int nN_, int G_, int c_, int K_, int nTail = 0, int nM2_ = 0, int nN2_ = 0) { nM = nM_; nN = nN_; nwg = nM * nN; G = G_; c = c_; ntK = K_ / BK; nsl = K_ / 256; nsplit = nTail * nN_ * nsl; nM2 = nM2_; nN2 = nN2_; nwg2 = nM2_ * nN2_; }
    DI static void tile(int wgid, int nwg_, int nM_, int nN_, Unit& u) {
        { const int q = nwg_ / NXCD, r = nwg_ % NXCD, xcd = wgid % NXCD, off = wgid / NXCD; wgid = (xcd < r ? xcd * (q + 1) : r * (q + 1) + (xcd - r) * q) + off; }
        const int nig = WGM * nN_, gid = wgid / nig, fm = gid * WGM, gsz = (nM_ - fm) < WGM ? (nM_ - fm) : WGM;
        u.pm = fm + ((wgid % nig) % gsz); u.pn = (wgid % nig) / gsz;
    }
    DI bool next(int i, Unit& u) const {
        const long L = (long)i * G + c; if (L >= nwg + nwg2 + nsplit) return false;
        u.k0 = 0; u.nt = ntK; u.kind = 0;
        if (L < nwg) { tile((int)L, nwg, nM, nN, u); return true; }
        if (L < nwg + nwg2) { tile((int)L - nwg, nwg2, nM2, nN2, u); u.kind = 1; return true; }
        const int L2 = (int)L - nwg - nwg2; const int sl = L2 % nsl, tl = L2 / nsl; u.pm = nM + (tl & 3); u.pn = tl >> 2; u.k0 = sl * 256; u.nt = 4; return true;
    }
};
template <class Epi>
DI void gemm_phase(LAS unsigned char* lds, const Gemm g, const StaticOrder S, const Epi E) {
    const int tid = tid_opaque(), wid = __builtin_amdgcn_readfirstlane(tid >> 6), lane = tid & 63, wr = wid >> 2, wc = wid & 3, fr = lane & 15, fq = lane >> 4;
    unsigned voffA[2], voffB[2];
#pragma unroll
    for (int i = 0; i < 2; ++i) { int R, C; stage_rc(tid * 16 + i * 8192, R, C); const int Rb = Epi::PERM ? ((R & ~31) + perm32(R & 31)) : R;
        voffA[i] = (unsigned)(R * g.lda + C) * 2u; voffB[i] = (unsigned)(Rb * g.ldb + C) * 2u; }
    const size_t kstep = (size_t)(BK * 2);
    const size_t hstepA = (size_t)HALF * g.lda * 2, hstepB = (size_t)HALF * g.ldb * 2;
    const size_t tstepA = 2 * hstepA, tstepB = 2 * hstepB;
    const size_t pnoffA = (size_t)g.a_pn_off * 2;
    const unsigned ldsw = (unsigned)wid * 1024u;
    const int aoff = lds_byte(wr * 64 + fr, fq * 8), boff = lds_byte(wc * 32 + fr, fq * 8);
#define PG8_SA(b, h) (((b) * 2 + (h)) * HTB)
#define PG8_SB(b, h) ((4 + (b) * 2 + (h)) * HTB)
#define PG8_STAGE(bufoff, gbase, voff) do { _Pragma("unroll") for (int _i = 0; _i < 2; ++_i) \
        __builtin_amdgcn_global_load_lds((const unsigned*)((const char*)(gbase) + (voff)[_i]), (LAS unsigned*)(lds + (bufoff) + ldsw + _i * 8192), 16, 0, 0); } while (0)
#define PG8_LDA(dst, b, h) do { _Pragma("unroll") for (int m = 0; m < 4; ++m) _Pragma("unroll") for (int k = 0; k < 2; ++k) dst[m][k] = *(const LAS bf16x8*)(lds + PG8_SA(b, h) + aoff + m * 2048 + k * 1024); } while (0)
#define PG8_LDB(dst, b, h) do { _Pragma("unroll") for (int n = 0; n < 2; ++n) _Pragma("unroll") for (int k = 0; k < 2; ++k) dst[n][k] = *(const LAS bf16x8*)(lds + PG8_SB(b, h) + boff + n * 2048 + k * 1024); } while (0)
#define PG8_MMA(ai, bj, At, Bt) do { __builtin_amdgcn_s_setprio(1); _Pragma("unroll") for (int m = 0; m < 4; ++m) _Pragma("unroll") for (int n = 0; n < 2; ++n) _Pragma("unroll") for (int k = 0; k < 2; ++k) \
        acc[ai][bj][m][n] = __builtin_amdgcn_mfma_f32_16x16x32_bf16(Bt[n][k], At[m][k], acc[ai][bj][m][n], 0, 0, 0); __builtin_amdgcn_s_setprio(0); } while (0)
#define PG8_WAIT_V(n) asm volatile("s_waitcnt vmcnt(" #n ")" ::: "memory")
#define PG8_WAIT_L(n) asm volatile("s_waitcnt lgkmcnt(" #n ")" ::: "memory")
#define PG8_BAR __builtin_amdgcn_s_barrier()
#define PG8_SCHED __builtin_amdgcn_sched_barrier(0)
    Unit cur, nxt; int ui = 0;
    if (!S.next(0, cur)) return;
    f32x4 acc[2][2][4][2];
#pragma unroll
    for (int a = 0; a < 2; ++a)
#pragma unroll
        for (int b = 0; b < 2; ++b)
#pragma unroll
            for (int m = 0; m < 4; ++m)
#pragma unroll
                for (int n = 0; n < 2; ++n) acc[a][b][m][n] = (f32x4){0.f, 0.f, 0.f, 0.f};
    bf16x8 At[4][2], B0[2][2], B1[2][2];
    const char* cA = (const char*)(cur.kind ? g.A2 : g.A) + (size_t)cur.pm * tstepA + (size_t)cur.pn * pnoffA + (size_t)cur.k0 * 2; const char* cB = (const char*)(cur.kind ? g.Bt2 : g.Bt) + (size_t)cur.pn * tstepB + (size_t)cur.k0 * 2;
    PG8_STAGE(PG8_SB(0, 0), cB, voffB); PG8_STAGE(PG8_SB(0, 1), cB + hstepB, voffB); PG8_STAGE(PG8_SA(0, 0), cA, voffA); PG8_STAGE(PG8_SA(0, 1), cA + hstepA, voffA);
    if (wr == 1) PG8_BAR;
    PG8_WAIT_V(2); PG8_BAR;
    PG8_STAGE(PG8_SB(1, 0), cB + kstep, voffB); PG8_STAGE(PG8_SA(1, 0), cA + kstep, voffA); PG8_STAGE(PG8_SB(1, 1), cB + hstepB + kstep, voffB);
    PG8_WAIT_V(6); PG8_BAR;
    for (;;) {
        const bool has_next = S.next(ui + 1, nxt);
        const char* nA = has_next ? (const char*)(nxt.kind ? g.A2 : g.A) + (size_t)nxt.pm * tstepA + (size_t)nxt.pn * pnoffA + (size_t)nxt.k0 * 2 : cA; const char* nB = has_next ? (const char*)(nxt.kind ? g.Bt2 : g.Bt) + (size_t)nxt.pn * tstepB + (size_t)nxt.k0 * 2 : cB;
        const int nt = cur.nt;
        for (int t = 0; t < nt; t += 2) {
            const bool last = (t == nt - 2);
            const char* a1 = cA + (size_t)(t + 1) * kstep;
            const char* a2 = last ? nA : cA + (size_t)(t + 2) * kstep; const char* b2 = last ? nB : cB + (size_t)(t + 2) * kstep;
            const char* a3 = a2 + kstep; const char* b3 = b2 + kstep;
            PG8_LDB(B0, 0, 0); PG8_LDB(B1, 0, 1); PG8_SCHED; PG8_LDA(At, 0, 0); PG8_STAGE(PG8_SA(1, 1), a1 + hstepA, voffA);
            PG8_WAIT_V(8); PG8_WAIT_L(0); PG8_BAR; PG8_MMA(0, 0, At, B0); PG8_MMA(0, 1, At, B1); PG8_BAR; PG8_SCHED;
            PG8_LDA(At, 0, 1); PG8_STAGE(PG8_SB(0, 0), b2, voffB); PG8_STAGE(PG8_SB(0, 1), b2 + hstepB, voffB); PG8_STAGE(PG8_SA(0, 0), a2, voffA);
            PG8_WAIT_V(8); PG8_WAIT_L(0); PG8_BAR; PG8_MMA(1, 0, At, B0); PG8_MMA(1, 1, At, B1); PG8_BAR; PG8_SCHED;
            PG8_LDB(B0, 1, 0); PG8_LDB(B1, 1, 1); PG8_SCHED; PG8_LDA(At, 1, 0); PG8_STAGE(PG8_SA(0, 1), a2 + hstepA, voffA);
            PG8_WAIT_V(8); PG8_WAIT_L(0); PG8_BAR; PG8_MMA(0, 0, At, B0); PG8_MMA(0, 1, At, B1); PG8_BAR; PG8_SCHED;
            PG8_LDA(At, 1, 1); PG8_STAGE(PG8_SB(1, 0), b3, voffB); PG8_STAGE(PG8_SB(1, 1), b3 + hstepB, voffB); PG8_STAGE(PG8_SA(1, 0), a3, voffA);
            PG8_WAIT_V(8); PG8_WAIT_L(0); PG8_BAR; PG8_MMA(1, 0, At, B0); PG8_MMA(1, 1, At, B1); PG8_BAR; PG8_SCHED;
        }
        if (wr == 0) PG8_BAR;
        E(acc, cur, wr, wc, fr, fq);
        if (!has_next) break;
#pragma unroll
        for (int a = 0; a < 2; ++a)
#pragma unroll
            for (int b = 0; b < 2; ++b)
#pragma unroll
                for (int m = 0; m < 4; ++m)
#pragma unroll
                    for (int n = 0; n < 2; ++n) acc[a][b][m][n] = (f32x4){0.f, 0.f, 0.f, 0.f};
        cur = nxt; cA = nA; cB = nB; ++ui;
        if (wr == 1) PG8_BAR;
    }
    PG8_WAIT_V(0);
    PG8_BAR;
#undef PG8_SA
#undef PG8_SB
#undef PG8_STAGE
#undef PG8_LDA
#undef PG8_LDB
#undef PG8_MMA
#undef PG8_WAIT_V
#undef PG8_WAIT_L
#undef PG8_BAR
#undef PG8_SCHED
}
}
using pg8::Unit;
typedef f32x4 AccT[2][2][4][2];

struct EpiSwiglu {
    static constexpr bool PERM = true;
    bf16_t* O;
    DI void operator()(const AccT& acc, const Unit& u, int wr, int wc, int fr, int fq) const {
        asm volatile("" : "+v"(fr), "+v"(fq));
        const int row0 = u.pm * 256 + wr * 64 + fr, col0 = u.pn * 128 + wc * 32 + 8 * fq;
#pragma unroll
        for (int ai = 0; ai < 2; ++ai)
#pragma unroll
            for (int m = 0; m < 4; ++m) {
                bf16_t* p = O + (size_t)(row0 + ai * 128 + m * 16) * FF + col0;
                float v[8];
#pragma unroll
                for (int n = 0; n < 2; ++n)
#pragma unroll
                    for (int i = 0; i < 4; ++i) v[n * 4 + i] = silu_f(acc[ai][0][m][n][i]) * acc[ai][1][m][n][i];
                u32x4 w; w.x = pk2(v[0], v[1]); w.y = pk2(v[2], v[3]); w.z = pk2(v[4], v[5]); w.w = pk2(v[6], v[7]);
                *(u32x4*)p = w; __builtin_amdgcn_sched_barrier(0);
            }
    }
};
struct EpiResid {
    static constexpr bool PERM = true;
    float* H; const float* Hsrc; const float* gate; const float* colscale; float* P; float w; float pad_;
    DI void operator()(const AccT& acc, const Unit& u, int wr, int wc, int fr, int fq) const {
        asm volatile("" : "+v"(fr), "+v"(fq));
        const int mr = u.pm < 64 ? (u.pm >> 4) : 4; const bool split = u.pm >= 64;
        const int row0 = u.pm * 256 + wr * 64 + fr, col0 = u.pn * 256 + wc * 32 + 8 * fq;
        const float* g = gate + (size_t)mr * MODW + col0;
#pragma unroll
        for (int bj = 0; bj < 2; ++bj) {
            f32x4 g0 = *(const f32x4*)(g + bj * 128) * w, g1 = *(const f32x4*)(g + bj * 128 + 4) * w;
            if (colscale) { g0 = g0 * *(const f32x4*)(colscale + col0 + bj * 128); g1 = g1 * *(const f32x4*)(colscale + col0 + bj * 128 + 4); }
#pragma unroll
            for (int ai = 0; ai < 2; ++ai) {
                if (split) {
#pragma unroll
                    for (int m = 0; m < 4; ++m) {
                        float* q = P + ((size_t)(u.k0 >> 8) * MC + (row0 + ai * 128 + m * 16 - ML)) * D + col0 + bj * 128;
                        *(f32x4*)q = g0 * acc[ai][bj][m][0]; *(f32x4*)(q + 4) = g1 * acc[ai][bj][m][1];
                    }
                } else {
                    float* p = H + (size_t)(row0 + ai * 128) * D + col0 + bj * 128;
                    const float* ps = Hsrc + (size_t)(row0 + ai * 128) * D + col0 + bj * 128;
                    f32x4 h[4][2];
#pragma unroll
                    for (int m = 0; m < 4; ++m) { h[m][0] = *(const f32x4*)(ps + (size_t)m * 16 * D); h[m][1] = *(const f32x4*)(ps + (size_t)m * 16 * D + 4); }
#pragma unroll
                    for (int m = 0; m < 4; ++m) { h[m][0] = h[m][0] + g0 * acc[ai][bj][m][0]; h[m][1] = h[m][1] + g1 * acc[ai][bj][m][1]; }
#pragma unroll
                    for (int m = 0; m < 4; ++m) { *(f32x4*)(p + (size_t)m * 16 * D) = h[m][0]; *(f32x4*)(p + (size_t)m * 16 * D + 4) = h[m][1]; }
                }
                __builtin_amdgcn_sched_barrier(0);
            }
        }
    }
};
struct EpiBf16 {
    static constexpr bool PERM = true;
    bf16_t* O; int ldc; int nsc; float sc; int cm_rows; int pad_;
    DI void operator()(const AccT& acc, const Unit& u, int wr, int wc, int fr, int fq) const {
        asm volatile("" : "+v"(fr), "+v"(fq));
        const float s = u.pn < nsc ? sc : 1.f;
        const int row0 = u.pm * 256 + wr * 64 + fr, col0 = u.pn * 256 + wc * 32 + 8 * fq;
#pragma unroll
        for (int ai = 0; ai < 2; ++ai)
#pragma unroll
            for (int m = 0; m < 4; ++m)
#pragma unroll
                for (int bj = 0; bj < 2; ++bj) {
                    const int rr_ = row0 + ai * 128 + m * 16, cc_ = col0 + bj * 128;
                    bf16_t* p = cm_rows ? O + ((size_t)(cc_ >> 6) * cm_rows + rr_) * 64 + (cc_ & 63) : O + (size_t)rr_ * ldc + cc_;
                    const f32x4 v0 = acc[ai][bj][m][0] * s, v1 = acc[ai][bj][m][1] * s;
                    u32x4 w; w.x = pk2(v0[0], v0[1]); w.y = pk2(v0[2], v0[3]); w.z = pk2(v1[0], v1[1]); w.w = pk2(v1[2], v1[3]);
                    *(u32x4*)p = w; __builtin_amdgcn_sched_barrier(0);
                }
    }
};
struct EpiRetNat {
    static constexpr bool PERM = true;
    bf16_t* G; bf16_t* Q; bf16_t* Kb; const f32x2* cs;
    DI void operator()(const AccT& acc, const Unit& u, int wr, int wc, int fr, int fq) const {
        asm volatile("" : "+v"(fr), "+v"(fq));
        const int row0 = u.pm * 256 + wr * 64 + fr;
        if (u.pn < 8) {
            const int col0 = u.pn * 256 + wc * 32 + 8 * fq;
#pragma unroll
            for (int ai = 0; ai < 2; ++ai)
#pragma unroll
                for (int m = 0; m < 4; ++m)
#pragma unroll
                    for (int bj = 0; bj < 2; ++bj) {
                        bf16_t* p = G + (size_t)(row0 + ai * 128 + m * 16) * 2048 + col0 + bj * 128;
                        const f32x4 v0 = acc[ai][bj][m][0], v1 = acc[ai][bj][m][1];
                        u32x4 w; w.x = pk2(silu_f(v0[0]), silu_f(v0[1])); w.y = pk2(silu_f(v0[2]), silu_f(v0[3])); w.z = pk2(silu_f(v1[0]), silu_f(v1[1])); w.w = pk2(silu_f(v1[2]), silu_f(v1[3]));
                        *(u32x4*)p = w; __builtin_amdgcn_sched_barrier(0);
                    }
            return;
        }
        const bool isk = u.pn >= 12; const int head = (u.pn - 8) & 3; const float sc = isk ? 0.0625f : 1.f;
        bf16_t* dst = isk ? Kb : Q; const bool lat = u.pm < 64;
        const int dl0 = wc * 32 + 8 * fq;
#pragma unroll
        for (int ai = 0; ai < 2; ++ai)
#pragma unroll
            for (int m = 0; m < 4; ++m) {
                const int row = row0 + ai * 128 + m * 16;
                float x0[8], x1[8];
#pragma unroll
                for (int n = 0; n < 2; ++n)
#pragma unroll
                    for (int i = 0; i < 4; ++i) { x0[n * 4 + i] = acc[ai][0][m][n][i] * sc; x1[n * 4 + i] = acc[ai][1][m][n][i] * sc; }
                if (lat) {
                    const f32x4* cp = (const f32x4*)(cs + (size_t)(row & 4095) * 128 + dl0);
#pragma unroll
                    for (int q = 0; q < 4; ++q) { const f32x4 c = cp[q];
                        const float a0 = x0[2 * q], b0 = x1[2 * q], a1 = x0[2 * q + 1], b1 = x1[2 * q + 1];
                        x0[2 * q] = a0 * c[0] - b0 * c[1]; x1[2 * q] = b0 * c[0] + a0 * c[1];
                        x0[2 * q + 1] = a1 * c[2] - b1 * c[3]; x1[2 * q + 1] = b1 * c[2] + a1 * c[3]; }
                }
                bf16_t* p = dst + (size_t)row * 1024 + head * 256 + dl0;
                u32x4 w0, w1; w0.x = pk2(x0[0], x0[1]); w0.y = pk2(x0[2], x0[3]); w0.z = pk2(x0[4], x0[5]); w0.w = pk2(x0[6], x0[7]);
                w1.x = pk2(x1[0], x1[1]); w1.y = pk2(x1[2], x1[3]); w1.z = pk2(x1[4], x1[5]); w1.w = pk2(x1[6], x1[7]);
                *(u32x4*)p = w0; *(u32x4*)(p + 128) = w1;
            }
    }
};
struct EpiRetSwp {
    static constexpr bool PERM = true;
    bf16_t* KTf; bf16_t* KTb; bf16_t* VT; const f32x2* csT; const float* dec;
    DI void operator()(const AccT& acc, const Unit& u, int wr, int wc, int fr, int fq) const {
        asm volatile("" : "+v"(fr), "+v"(fq));
        const int col0 = u.pn * 256 + wc * 32 + 8 * fq;
        if (u.pm >= 4) {
            const int row0 = (u.pm - 4) * 256 + wr * 64 + fr;
#pragma unroll
            for (int ai = 0; ai < 2; ++ai)
#pragma unroll
                for (int m = 0; m < 4; ++m)
#pragma unroll
                    for (int bj = 0; bj < 2; ++bj) {
                        const int cc_ = col0 + bj * 128; bf16_t* p = VT + ((size_t)(cc_ >> 6) * 2048 + (row0 + ai * 128 + m * 16)) * 64 + (cc_ & 63);
                        const f32x4 v0 = acc[ai][bj][m][0], v1 = acc[ai][bj][m][1];
                        u32x4 w; w.x = pk2(v0[0], v0[1]); w.y = pk2(v0[2], v0[3]); w.z = pk2(v1[0], v1[1]); w.w = pk2(v1[2], v1[3]);
                        *(u32x4*)p = w; __builtin_amdgcn_sched_barrier(0);
                    }
            return;
        }
        const int head = u.pm; const bool lat = u.pn < 64;
        const int pos0 = 32 * (wc & 1) + 8 * fq;
        const float lgf = dec[head], lgb = dec[4 + head];
        float kdf[8], kdb[8];
#pragma unroll
        for (int e = 0; e < 8; ++e) { kdf[e] = 0.0625f * __builtin_amdgcn_exp2f(lgf * (float)(63 - pos0 - e)); kdb[e] = 0.0625f * __builtin_amdgcn_exp2f(lgb * (float)(pos0 + e)); }
#pragma unroll
        for (int m = 0; m < 4; ++m) {
            const int dl = wr * 64 + m * 16 + fr;
#pragma unroll
            for (int bj = 0; bj < 2; ++bj) {
                const int c0 = col0 + bj * 128;
                const f32x4* cp = (const f32x4*)(csT + (size_t)dl * 4096 + (c0 & 4095));
                const size_t o0 = ((size_t)(c0 >> 6) * 1024 + head * 256 + dl) * 64 + (c0 & 63), o1 = o0 + (size_t)128 * 64;
                float p[8], q[8];
#pragma unroll
                for (int n = 0; n < 2; ++n) {
                    f32x4 ca = (f32x4){1.f, 0.f, 1.f, 0.f}, cb = ca;
                    if (lat) { ca = cp[2 * n]; cb = cp[2 * n + 1]; }
                    const f32x4 x0 = acc[0][bj][m][n], x1 = acc[1][bj][m][n];
                    p[4 * n + 0] = x0[0] * ca[0] - x1[0] * ca[1]; q[4 * n + 0] = x1[0] * ca[0] + x0[0] * ca[1];
                    p[4 * n + 1] = x0[1] * ca[2] - x1[1] * ca[3]; q[4 * n + 1] = x1[1] * ca[2] + x0[1] * ca[3];
                    p[4 * n + 2] = x0[2] * cb[0] - x1[2] * cb[1]; q[4 * n + 2] = x1[2] * cb[0] + x0[2] * cb[1];
                    p[4 * n + 3] = x0[3] * cb[2] - x1[3] * cb[3]; q[4 * n + 3] = x1[3] * cb[2] + x0[3] * cb[3];
                }
                u32x4 w;
                w.x = pk2(p[0] * kdf[0], p[1] * kdf[1]); w.y = pk2(p[2] * kdf[2], p[3] * kdf[3]); w.z = pk2(p[4] * kdf[4], p[5] * kdf[5]); w.w = pk2(p[6] * kdf[6], p[7] * kdf[7]); *(u32x4*)(KTf + o0) = w;
                w.x = pk2(q[0] * kdf[0], q[1] * kdf[1]); w.y = pk2(q[2] * kdf[2], q[3] * kdf[3]); w.z = pk2(q[4] * kdf[4], q[5] * kdf[5]); w.w = pk2(q[6] * kdf[6], q[7] * kdf[7]); *(u32x4*)(KTf + o1) = w;
                w.x = pk2(p[0] * kdb[0], p[1] * kdb[1]); w.y = pk2(p[2] * kdb[2], p[3] * kdb[3]); w.z = pk2(p[4] * kdb[4], p[5] * kdb[5]); w.w = pk2(p[6] * kdb[6], p[7] * kdb[7]); *(u32x4*)(KTb + o0) = w;
                w.x = pk2(q[0] * kdb[0], q[1] * kdb[1]); w.y = pk2(q[2] * kdb[2], q[3] * kdb[3]); w.z = pk2(q[4] * kdb[4], q[5] * kdb[5]); w.w = pk2(q[6] * kdb[6], q[7] * kdb[7]); *(u32x4*)(KTb + o1) = w;

            }
        }
    }
};
struct EpiSwaNat {
    static constexpr bool PERM = true; static constexpr bool HOOK = false;
    bf16_t* O; const f32x2* cs2;
    DI void operator()(const AccT& acc, const Unit& u, int wr, int wc, int fr, int fq) const {
        asm volatile("" : "+v"(fr), "+v"(fq));
        const float sc = u.pn < 4 ? 0.125f : 1.f; const bool lat = u.pm < 64; const int axis = wc & 1;
        const int row0 = u.pm * 256 + wr * 64 + fr, col0 = u.pn * 256 + wc * 32 + 8 * fq;
        const int lane = fr + 16 * fq; const float sgn = (fq >> 1) ? 1.f : -1.f;
#pragma unroll
        for (int ai = 0; ai < 2; ++ai)
#pragma unroll
            for (int m = 0; m < 4; ++m) {
                const int row = row0 + ai * 128 + m * 16; const int t = row & 4095; const int pos = axis ? (t & 63) : (t >> 6);
                f32x4 c0 = (f32x4){1.f, 0.f, 1.f, 0.f}, c1 = c0, c2 = c0, c3 = c0;
                if (lat) { const f32x4* cp = (const f32x4*)(cs2 + pos * 16 + 8 * (fq & 1)); c0 = cp[0]; c1 = cp[1]; c2 = cp[2]; c3 = cp[3]; }
#pragma unroll
                for (int bj = 0; bj < 2; ++bj) {
                    const f32x4 x0 = acc[ai][bj][m][0], x1 = acc[ai][bj][m][1];
                    f32x4 y0, y1;
#pragma unroll
                    for (int i = 0; i < 4; ++i) { y0[i] = shx(x0[i], 32, lane); y1[i] = shx(x1[i], 32, lane); }
                    float o[8];
                    o[0] = x0[0] * c0[0] + sgn * y0[0] * c0[1]; o[1] = x0[1] * c0[2] + sgn * y0[1] * c0[3];
                    o[2] = x0[2] * c1[0] + sgn * y0[2] * c1[1]; o[3] = x0[3] * c1[2] + sgn * y0[3] * c1[3];
                    o[4] = x1[0] * c2[0] + sgn * y1[0] * c2[1]; o[5] = x1[1] * c2[2] + sgn * y1[1] * c2[3];
                    o[6] = x1[2] * c3[0] + sgn * y1[2] * c3[1]; o[7] = x1[3] * c3[2] + sgn * y1[3] * c3[3];
                    bf16_t* p = O + (size_t)row * 1280 + col0 + bj * 128;
                    u32x4 w; w.x = pk2(o[0] * sc, o[1] * sc); w.y = pk2(o[2] * sc, o[3] * sc); w.z = pk2(o[4] * sc, o[5] * sc); w.w = pk2(o[6] * sc, o[7] * sc);
                    *(u32x4*)p = w;
                }
            }
    }
};
template <class E1, class E2> struct EpiDual {
    static constexpr bool PERM = true, HOOK = false;
    E1 e1; E2 e2;
    DI void operator()(const AccT& acc, const Unit& u, int wr, int wc, int fr, int fq) const { if (u.kind) e2(acc, u, wr, wc, fr, fq); else e1(acc, u, wr, wc, fr, fq); }
};
struct Args { const float* in[23]; float* out; unsigned char* ws; int ph_lo, ph_hi; };
struct Ctx { unsigned char* ws; float* out; const float* normg; const float* fng; const float* rgn; const float* aux_nat; const float* aux_swa; const float* psc; const float* x; const float* ctx; };
DI const float* inp_ld(const unsigned char* ws, int i) { const unsigned long long p = ((const unsigned long long*)(ws + OFF_PTAB))[i];
    const unsigned lo = __builtin_amdgcn_readfirstlane((unsigned)p), hi = __builtin_amdgcn_readfirstlane((unsigned)(p >> 32)); return (const float*)(const __attribute__((address_space(1))) float*)(((unsigned long long)hi << 32) | lo); }
#define INP(a_, i_) inp_ld((a_).ws, (i_))
enum { I_X = 0, I_C, I_CTX, I_CCTX, I_WMOD, I_BMOD, I_NORMG, I_FWIN, I_FWOUT, I_RWIN, I_RWOUT, I_RGN, I_RDF, I_RDB, I_NWQKV, I_NWO, I_NRPB, I_PW, I_PSC, I_SWQKV, I_SWO, I_SSINK, I_FNG };

DI void transpose_item(const float* W, int K, int N, bf16_t* WT, int maptype, LAS float* scr, int item, int lane) {
    const int nblk = N / 64, kb = item / nblk, nb = item % nblk, k0 = 64 * kb, n0 = 64 * nb;
    int d0 = n0;
    if (maptype == 1) { const int j = n0 < FF ? n0 : n0 - FF; d0 = (j >> 7) * 256 + (n0 < FF ? 0 : 128) + (j & 127); }
    else if (maptype == 2) { d0 = n0 < 4096 ? n0 + 2048 : n0 - 4096; }
    const int lr = lane >> 4, lc = 4 * (lane & 15);
    f32x4 v[16];
#pragma unroll
    for (int i = 0; i < 16; ++i) v[i] = __builtin_nontemporal_load((const f32x4*)(W + (size_t)(k0 + 4 * i + lr) * N + n0 + lc));
#pragma unroll
    for (int i = 0; i < 16; ++i) { LAS float* p = scr + (4 * i + lr) * 65 + lc; p[0] = v[i][0]; p[1] = v[i][1]; p[2] = v[i][2]; p[3] = v[i][3]; }
    asm volatile("s_waitcnt lgkmcnt(0)" ::: "memory");
    const int c = lane & 7;
#pragma unroll
    for (int j = 0; j < 8; ++j) { const int n = (lane >> 3) + 8 * j; const LAS float* q = scr + (8 * c) * 65 + n;
        u32x4 o; o.x = pk2(q[0 * 65], q[1 * 65]); o.y = pk2(q[2 * 65], q[3 * 65]); o.z = pk2(q[4 * 65], q[5 * 65]); o.w = pk2(q[6 * 65], q[7 * 65]);
        *(u32x4*)(WT + (size_t)(d0 + n) * K + k0 + 8 * c) = o; }
    asm volatile("s_waitcnt lgkmcnt(0)" ::: "memory");
}

DI void prologue(const Args& a, LAS unsigned char* lds) {
    unsigned char* ws = a.ws;
    const int tid = tid_opaque(), lane = tid & 63, wave = tid >> 6;
    const int G = gridDim.x, gw = blockIdx.x * NWAVES + wave, NGW = G * NWAVES, gtid = blockIdx.x * NTHREADS + tid, NT = G * NTHREADS;
    if (blockIdx.x == 0 && tid < 23) ((const float**)(ws + OFF_PTAB))[tid] = a.in[tid];
    {
        f32x2* cs = (f32x2*)(ws + OFF_CS); f32x2* csT = (f32x2*)(ws + OFF_CST); f32x2* cs2 = (f32x2*)(ws + OFF_CS2); float* dec = (float*)(ws + OFF_DEC);
        for (int idx = gtid; idx < 4096 * 128; idx += NT) {
            const int t = idx >> 7, dl = idx & 127;
            const float inv = exp2f(-(float)dl * (13.287712379549449f / 128.f));
            const float ang = (float)t * inv;
            double rev = (double)ang * 0.15915494309189535; rev -= floor(rev);
            const float fr_ = (float)rev;
            f32x2 v; v.x = __builtin_amdgcn_cosf(fr_); v.y = __builtin_amdgcn_sinf(fr_);
            cs[idx] = v; csT[(size_t)dl * 4096 + t] = v;
        }
        if (gtid < 1024) {
            const int pos = gtid >> 4, f = gtid & 15;
            const float inv = exp2f(-(float)f * (13.287712379549449f / 16.f));
            const float ang = (float)pos * inv;
            double rev = (double)ang * 0.15915494309189535; rev -= floor(rev);
            const float fr_ = (float)rev;
            f32x2 v; v.x = __builtin_amdgcn_cosf(fr_); v.y = __builtin_amdgcn_sinf(fr_);
            cs2[gtid] = v;
        }
        if (gtid < 8) { const float x = gtid < 4 ? a.in[I_RDF][gtid] : a.in[I_RDB][gtid - 4]; dec[gtid] = -log1pf(expf(-x)) * LOG2E; }
    }
    {
        LAS float* scr = (LAS float*)(lds + wave * 16640);
        constexpr int I_FI = 16 * 88, I_FO = 44 * 16, I_RI = 16 * 96, I_RO = 32 * 16, I_NQ = 16 * 48, I_NO = 16 * 16, I_PL = 4 * 4, I_SQ = 16 * 24, I_SO = 16 * 16;
        constexpr int NITEMS = 8 * I_FI + 8 * I_FO + I_RI + I_RO + I_NQ + I_NO + 4 * I_PL + I_SQ + I_SO;
        for (int it = gw; it < NITEMS; it += NGW) {
            int r = it;
            if (r < 8 * I_FI) { const int mi = r / I_FI; transpose_item(a.in[I_FWIN] + (size_t)mi * 1024 * 5632, 1024, 5632, (bf16_t*)(ws + OFF_WFI) + (size_t)mi * 5632 * 1024, 1, scr, r % I_FI, lane); continue; } r -= 8 * I_FI;
            if (r < 8 * I_FO) { const int mi = r / I_FO; transpose_item(a.in[I_FWOUT] + (size_t)mi * 2816 * 1024, 2816, 1024, (bf16_t*)(ws + OFF_WFO) + (size_t)mi * 1024 * 2816, 0, scr, r % I_FO, lane); continue; } r -= 8 * I_FO;
            if (r < I_RI) { transpose_item(a.in[I_RWIN], 1024, 6144, (bf16_t*)(ws + OFF_WRI), 2, scr, r, lane); continue; } r -= I_RI;
            if (r < I_RO) { transpose_item(a.in[I_RWOUT], 2048, 1024, (bf16_t*)(ws + OFF_WRO), 0, scr, r, lane); continue; } r -= I_RO;
            if (r < I_NQ) { transpose_item(a.in[I_NWQKV], 1024, 3072, (bf16_t*)(ws + OFF_WNQ), 0, scr, r, lane); continue; } r -= I_NQ;
            if (r < I_NO) { transpose_item(a.in[I_NWO], 1024, 1024, (bf16_t*)(ws + OFF_WNO), 0, scr, r, lane); continue; } r -= I_NO;
            if (r < 4 * I_PL) { const int mi = r / I_PL; transpose_item(a.in[I_PW] + (size_t)mi * 65536, 256, 256, (bf16_t*)(ws + OFF_WPL) + (size_t)mi * 65536, 0, scr, r % I_PL, lane); continue; } r -= 4 * I_PL;
            if (r < I_SQ) { transpose_item(a.in[I_SWQKV], 1024, 1536, (bf16_t*)(ws + OFF_WSQ), 0, scr, r, lane); continue; } r -= I_SQ;
            transpose_item(a.in[I_SWO], 1024, 1024, (bf16_t*)(ws + OFF_WSO), 0, scr, r, lane);
        }
    }
    __syncthreads();
    {
        LAS float* sv = (LAS float*)lds;
        LAS float* part = (LAS float*)(lds + 5 * 1024 * 4);
        for (int i = tid; i < 5 * 1024; i += NTHREADS) { const float x = i < 4096 ? a.in[I_C][i] : a.in[I_CCTX][i - 4096]; sv[i] = x / (1.f + expf(-x)); }
        __syncthreads();
        float* mod = (float*)(ws + OFF_MOD);
        for (int it = blockIdx.x; it < 4 * 36 * 8; it += G) {
            const int kq = it & 7, cb = (it >> 3) % 36, l = it / 288;
            const int kr0 = kq * 128 + wave * 16;
            const float* wp = a.in[I_WMOD] + (size_t)l * 1024 * MODW + (size_t)kr0 * MODW + cb * 256 + 4 * lane;
            f32x4 wv[16];
#pragma unroll
            for (int k = 0; k < 16; ++k) wv[k] = __builtin_nontemporal_load((const f32x4*)(wp + (size_t)k * MODW));
            f32x4 acc[5];
#pragma unroll
            for (int r = 0; r < 5; ++r) acc[r] = (f32x4){0.f, 0.f, 0.f, 0.f};
#pragma unroll
            for (int k = 0; k < 16; ++k)
#pragma unroll
                for (int r = 0; r < 5; ++r) acc[r] = acc[r] + wv[k] * sv[r * 1024 + kr0 + k];
#pragma unroll
            for (int r = 0; r < 5; ++r) *(LAS f32x4*)(part + (wave * 5 + r) * 256 + 4 * lane) = acc[r];
            __syncthreads();
            for (int o = tid; o < 5 * 256; o += NTHREADS) { const int r = o >> 8, c = o & 255; float sum = 0.f;
#pragma unroll
                for (int w8 = 0; w8 < 8; ++w8) sum += part[(w8 * 5 + r) * 256 + c];
                if (kq == 0) sum += a.in[I_BMOD][(size_t)l * MODW + cb * 256 + c];
                unsafeAtomicAdd(mod + ((size_t)l * 5 + r) * MODW + cb * 256 + c, sum); }
            __syncthreads();
        }
    }
}

DI void norm_phase(const Ctx& a, int layer, int sub, bool first, const float* P, int nsl, int nrows) {
    const int tid_ = tid_opaque(); const int lane = tid_ & 63, gw = blockIdx.x * NWAVES + (tid_ >> 6), NGW = gridDim.x * NWAVES;
    float* H = (float*)(a.ws + OFF_H); bf16_t* XN = (bf16_t*)(a.ws + OFF_XN);
    const float* g = a.normg + (size_t)(layer * 3 + sub) * 1024;
    const float* modl = (const float*)(a.ws + OFF_MOD) + (size_t)layer * 5 * MODW + (sub * 3) * 1024;
    const float* px = a.x; const float* pc = a.ctx;
    const int rbeg = gw, rend = nrows;
    if (rbeg >= rend) return;
#define NP_SRC(r_) (first ? ((r_) < ML ? px + (size_t)(r_) * 1024 : pc + (size_t)((r_) - ML) * 1024) : H + (size_t)(r_) * 1024)
#define NP_LOAD(dst_, r_) do { const float* s_ = NP_SRC(r_); _Pragma("unroll") for (int j = 0; j < 4; ++j) dst_[j] = *(const f32x4*)(s_ + 4 * lane + 256 * j); } while (0)
    f32x4 gg[4], sc[4], sh[4], v[4], n1[4], n2[4];
#pragma unroll
    for (int j = 0; j < 4; ++j) { gg[j] = *(const f32x4*)(g + 4 * lane + 256 * j); n1[j] = (f32x4){0.f, 0.f, 0.f, 0.f}; n2[j] = n1[j]; sc[j] = n1[j]; sh[j] = n1[j]; }
    NP_LOAD(n1, rbeg);
    if (rbeg + NGW < rend) NP_LOAD(n2, rbeg + NGW);
    int mr_cur = -1, mr_nxt = -1; f32x4 scn[4], shn[4];
#pragma unroll
    for (int j = 0; j < 4; ++j) { scn[j] = (f32x4){0.f, 0.f, 0.f, 0.f}; shn[j] = scn[j]; }
    for (int row = rbeg; row < rend; row += NGW) {
#pragma unroll
        for (int j = 0; j < 4; ++j) { v[j] = n1[j]; n1[j] = n2[j]; }
        if (row + 2 * NGW < rend) NP_LOAD(n2, row + 2 * NGW);
        const int mr = row < ML ? (row >> 12) : 4;
        if (mr != mr_cur) {
            if (mr == mr_nxt) {
#pragma unroll
                for (int j = 0; j < 4; ++j) { sh[j] = shn[j]; sc[j] = scn[j]; }
            } else {
#pragma unroll
                for (int j = 0; j < 4; ++j) { sh[j] = *(const f32x4*)(modl + (size_t)mr * MODW + 4 * lane + 256 * j); sc[j] = *(const f32x4*)(modl + (size_t)mr * MODW + 1024 + 4 * lane + 256 * j) + 1.f; }
            }
            mr_cur = mr;
        }
        if (row + 2 * NGW < rend) {
            const int r2_ = row + 2 * NGW; const int mr2 = r2_ < ML ? (r2_ >> 12) : 4;
            if (mr2 != mr_cur && mr2 != mr_nxt) { mr_nxt = mr2;
#pragma unroll
                for (int j = 0; j < 4; ++j) { shn[j] = *(const f32x4*)(modl + (size_t)mr2 * MODW + 4 * lane + 256 * j); scn[j] = *(const f32x4*)(modl + (size_t)mr2 * MODW + 1024 + 4 * lane + 256 * j) + 1.f; } }
        }
        const bool fold = !first && row >= ML;
        float ss = 0.f;
        if (fold) {
            for (int sl0 = 0; sl0 < nsl; sl0 += 4) {
                f32x4 t[4][4]; float wq[4];
#pragma unroll
                for (int u = 0; u < 4; ++u) { const int sl = sl0 + u < nsl ? sl0 + u : nsl - 1; wq[u] = sl0 + u < nsl ? 1.f : 0.f;
#pragma unroll
                    for (int j = 0; j < 4; ++j) t[u][j] = *(const f32x4*)(P + ((size_t)sl * MC + (row - ML)) * D + 4 * lane + 256 * j); }
#pragma unroll
                for (int u = 0; u < 4; ++u)
#pragma unroll
                    for (int j = 0; j < 4; ++j) v[j] = v[j] + t[u][j] * wq[u];
            }
        }
#pragma unroll
        for (int j = 0; j < 4; ++j) ss += (v[j][0] * v[j][0] + v[j][1] * v[j][1]) + (v[j][2] * v[j][2] + v[j][3] * v[j][3]);
        const float rstd = 1.f / sqrtf(wave_sum(ss, lane) * (1.f / 1024.f) + 1e-6f);
#pragma unroll
        for (int j = 0; j < 4; ++j) {
            const int c = 4 * lane + 256 * j;
            if ((first && row >= ML) || fold) *(f32x4*)(H + (size_t)row * 1024 + c) = v[j];
            f32x4 y = v[j] * rstd * gg[j]; y = y * sc[j] + sh[j];
            u32x2 w; w.x = pk2(y[0], y[1]); w.y = pk2(y[2], y[3]);
            *(u32x2*)(XN + (size_t)row * 1024 + c) = w;
        }
    }
#undef NP_LOAD
#undef NP_SRC
}
DI void final_phase(const Ctx& a) {
    const int tid_ = tid_opaque(); const int lane = tid_ & 63, gw = blockIdx.x * NWAVES + (tid_ >> 6), NGW = gridDim.x * NWAVES;
    const float* H = (const float*)(a.ws + OFF_H); const float* g = a.fng;
    if (gw >= ML) return;
    f32x4 gg[4], v[4], n1[4], n2[4];
#pragma unroll
    for (int j = 0; j < 4; ++j) { gg[j] = *(const f32x4*)(g + 4 * lane + 256 * j); n1[j] = *(const f32x4*)(H + (size_t)gw * 1024 + 4 * lane + 256 * j); n2[j] = n1[j]; }
    if (gw + NGW < ML) {
#pragma unroll
        for (int j = 0; j < 4; ++j) n2[j] = *(const f32x4*)(H + (size_t)(gw + NGW) * 1024 + 4 * lane + 256 * j); }
    for (int row = gw; row < ML; row += NGW) {
#pragma unroll
        for (int j = 0; j < 4; ++j) { v[j] = n1[j]; n1[j] = n2[j]; }
        if (row + 2 * NGW < ML) {
#pragma unroll
            for (int j = 0; j < 4; ++j) n2[j] = *(const f32x4*)(H + (size_t)(row + 2 * NGW) * 1024 + 4 * lane + 256 * j); }
        float ss = 0.f;
#pragma unroll
        for (int j = 0; j < 4; ++j) ss += (v[j][0] * v[j][0] + v[j][1] * v[j][1]) + (v[j][2] * v[j][2] + v[j][3] * v[j][3]);
        const float rstd = 1.f / sqrtf(wave_sum(ss, lane) * (1.f / 1024.f) + 1e-6f);
#pragma unroll
        for (int j = 0; j < 4; ++j) { const int c = 4 * lane + 256 * j; *(f32x4*)(a.out + (size_t)row * 1024 + c) = v[j] * rstd * gg[j]; }
    }
}

DI void pool_phase(const Ctx& a) {
    const bf16_t* XN = (const bf16_t*)(a.ws + OFF_XN); bf16_t* PL = (bf16_t*)(a.ws + OFF_PL);
    const int NT = gridDim.x * NTHREADS;
    const int G_ = gridDim.x, vb_ = (G_ % 8 == 0) ? (int)(blockIdx.x % 8) * (G_ / 8) + (int)(blockIdx.x / 8) : (int)blockIdx.x;
    for (int idx = vb_ * NTHREADS + tid_opaque(); idx < MT * 128; idx += NT) {
        const int row = idx >> 7, cg8 = idx & 127, half = 1 << (cg8 >> 5);
        int base, t, T;
        if (row < ML) { base = row & ~4095; t = row & 4095; T = 4096; } else { const int rr = row - ML; base = ML + (rr & ~255); t = rr & 255; T = 256; }
        const int lo = t - half < 0 ? 0 : t - half, hi = t + half > T ? T : t + half;
        float s[8] = {0.f, 0.f, 0.f, 0.f, 0.f, 0.f, 0.f, 0.f};
        for (int uu = lo; uu < hi; uu += 4) {
            u32x4 v[4]; float wgt[4];
#pragma unroll
            for (int e = 0; e < 4; ++e) { const int ur = uu + e < hi ? uu + e : hi - 1; wgt[e] = uu + e < hi ? 1.f : 0.f; v[e] = *(const u32x4*)(XN + (size_t)(base + ur) * 1024 + cg8 * 8); }
#pragma unroll
            for (int e = 0; e < 4; ++e) { s[0] += wgt[e] * bflo(v[e].x); s[1] += wgt[e] * bfhi(v[e].x); s[2] += wgt[e] * bflo(v[e].y); s[3] += wgt[e] * bfhi(v[e].y);
                s[4] += wgt[e] * bflo(v[e].z); s[5] += wgt[e] * bfhi(v[e].z); s[6] += wgt[e] * bflo(v[e].w); s[7] += wgt[e] * bfhi(v[e].w); }
        }
        const float inv = 1.f / (float)(hi - lo);
        const u32x4 xv = *(const u32x4*)(XN + (size_t)row * 1024 + cg8 * 8);
        u32x4 o; o.x = pk2(s[0] * inv - bflo(xv.x), s[1] * inv - bfhi(xv.x)); o.y = pk2(s[2] * inv - bflo(xv.y), s[3] * inv - bfhi(xv.y));
        o.z = pk2(s[4] * inv - bflo(xv.z), s[5] * inv - bfhi(xv.z)); o.w = pk2(s[6] * inv - bflo(xv.w), s[7] * inv - bfhi(xv.w));
        *(u32x4*)(PL + (size_t)row * 1024 + cg8 * 8) = o;
    }
}

constexpr int RC_SQ = 0, RC_SK = 32768, RC_SS = 65536, RC_SKT = 98304, RC_SVT = 131072, RC_SP = 139264;
DI void ret_chain_phase(const Ctx& a, LAS unsigned char* lds) {
    const bf16_t* Q = (const bf16_t*)(a.ws + OFF_RQ); const bf16_t* Kb = (const bf16_t*)(a.ws + OFF_RK);
    const bf16_t* VT = (const bf16_t*)(a.ws + OFF_RVT); const float* dec = (const float*)(a.ws + OFF_DEC);
    const int tid = tid_opaque(), wid = tid >> 6, lane = tid & 63, fr = lane & 15, fq = lane >> 4;
    for (int cid = blockIdx.x; cid < 256; cid += gridDim.x) {
        const int xq = cid & 7, yq = cid >> 3, grp = xq * 4 + (yq >> 3), vs = yq & 7;
        const int dir = grp & 1, h = (grp >> 1) & 3, b = grp >> 3;
        const float lg2 = dec[dir * 4 + h];
        const bf16_t* KT = (const bf16_t*)(a.ws + (dir ? OFF_RKTB : OFF_RKTF));
        bf16_t* O = (bf16_t*)(a.ws + OFF_ACT) + (dir ? (size_t)MT * 2048 : 0);
        f32x4 accS[2][4];
#pragma unroll
        for (int i = 0; i < 2; ++i)
#pragma unroll
            for (int j = 0; j < 4; ++j) accS[i][j] = (f32x4){0.f, 0.f, 0.f, 0.f};
        for (int i = tid; i < 32768 / 16; i += NTHREADS) *(LAS u32x4*)(lds + RC_SS + i * 16) = (u32x4){0u, 0u, 0u, 0u};
        const int it = wid & 3, half = wid >> 2;
        const int icol = 16 * it + fr;
        const float qdec = __builtin_amdgcn_exp2f(lg2 * (float)(dir ? 64 - icol : icol + 1));
        const float cdec = __builtin_amdgcn_exp2f(lg2 * 64.f);
        float wdec[2][4];
#pragma unroll
        for (int j2 = 0; j2 < 2; ++j2)
#pragma unroll
            for (int r = 0; r < 4; ++r) { const int j = 16 * (2 * half + j2) + 4 * fq + r; const int dd = dir ? (j - icol) : (icol - j); const bool keep = dir ? (dd > 0) : (dd >= 0);
                wdec[j2][r] = keep ? __builtin_amdgcn_exp2f(lg2 * (float)dd) : 0.f; }
        __syncthreads();
        u32x4 pkt[4], pvt;
#define RC_ROW0(s_) ((s_) < 4 ? ML + b * 256 + 64 * (dir ? 3 - (s_) : (s_)) : b * 4096 + 64 * (dir ? 67 - (s_) : (s_) - 4))
#define RC_ISSUE(s_) do { const int r0_ = RC_ROW0(s_); \
            _Pragma("unroll") for (int k = 0; k < 4; ++k) { const int p = tid + k * NTHREADS; const int d = p >> 3, ch = p & 7; \
                pkt[k] = *(const u32x4*)(KT + ((size_t)(r0_ >> 6) * 1024 + h * 256 + d) * 64 + ch * 8); } \
            { const int v_ = tid >> 3, ch = tid & 7; pvt = *(const u32x4*)(VT + ((size_t)(r0_ >> 6) * 2048 + h * 512 + vs * 64 + v_) * 64 + ch * 8); } } while (0)
        const int qk_src = ((tid >> 5) * 1024 + h * 256 + (((tid & 31) ^ ((tid >> 5) & 15)) * 8)) * 2;
#define RC_DMA_QK(s_) do { const size_t rb_ = (size_t)RC_ROW0(s_) * 2048 + qk_src; \
            _Pragma("unroll") for (int k = 0; k < 4; ++k) { \
                __builtin_amdgcn_global_load_lds((const unsigned*)((const char*)Q + rb_ + (size_t)k * 16 * 2048), (LAS unsigned*)(lds + RC_SQ + k * 8192 + wid * 1024), 16, 0, 0); \
                __builtin_amdgcn_global_load_lds((const unsigned*)((const char*)Kb + rb_ + (size_t)k * 16 * 2048), (LAS unsigned*)(lds + RC_SK + k * 8192 + wid * 1024), 16, 0, 0); } } while (0)
        RC_ISSUE(0);
        RC_DMA_QK(0);
        for (int s = 0; s < 68; ++s) {
            const int row0 = RC_ROW0(s);
#pragma unroll
            for (int k = 0; k < 4; ++k) { const int p = tid + k * NTHREADS; const int d = p >> 3, ch = p & 7;
                *(LAS u32x4*)(lds + RC_SKT + d * 128 + ((ch ^ ((d >> 1) & 7)) << 4)) = pkt[k]; }
            { const int v_ = tid >> 3, ch = tid & 7;
                *(LAS u32x4*)(lds + RC_SVT + v_ * 128 + ((ch ^ ((v_ >> 1) & 7)) << 4)) = pvt; }
            asm volatile("s_waitcnt vmcnt(0)" ::: "memory");
            if (s + 1 < 68) RC_ISSUE(s + 1);
            LDS_BARRIER();
            int frx = fr; asm volatile("" : "+v"(frx));
            const int sw5 = frx * 512, sw1 = frx * 128, kx = (frx >> 1) & 7;
#define A512(base_, t_, ks_) ((base_) + (t_) * 8192 + sw5 + ((((ks_) * 4 + fq) ^ frx) << 4))
#define A128(base_, t_, k2_) ((base_) + (t_) * 2048 + sw1 + ((((k2_) * 4 + fq) ^ kx) << 4))
            bf16x8 qf[8];
#pragma unroll
            for (int ks = 0; ks < 8; ++ks) qf[ks] = *(const LAS bf16x8*)(lds + A512(RC_SQ, it, ks));
#pragma unroll
            for (int j2 = 0; j2 < 2; ++j2) {
                const int jt = 2 * half + j2;
                f32x4 acc = (f32x4){0.f, 0.f, 0.f, 0.f};
#pragma unroll
                for (int ks = 0; ks < 8; ++ks) { const bf16x8 kf = *(const LAS bf16x8*)(lds + A512(RC_SK, jt, ks)); acc = MFMA16(kf, qf[ks], acc); }
                float pv[4];
#pragma unroll
                for (int r = 0; r < 4; ++r) pv[r] = acc[r] * wdec[j2][r];
                u32x2 w; w.x = pk2(pv[0], pv[1]); w.y = pk2(pv[2], pv[3]);
                *(LAS u32x2*)(lds + RC_SP + icol * 128 + (((2 * jt + (fq >> 1)) ^ ((icol >> 1) & 7)) << 4) + (fq & 1) * 8) = w;
            }
            f32x4 accO[2];
#pragma unroll
            for (int vv = 0; vv < 2; ++vv) {
                f32x4 acc = (f32x4){0.f, 0.f, 0.f, 0.f};
#pragma unroll
                for (int ks = 0; ks < 8; ++ks) { const bf16x8 sf = *(const LAS bf16x8*)(lds + A512(RC_SS, 2 * half + vv, ks)); acc = MFMA16(sf, qf[ks], acc); }
                accO[vv] = acc * qdec;
            }
            LDS_BARRIER();
            if (s + 1 < 68) RC_DMA_QK(s + 1);
#pragma unroll
            for (int vv = 0; vv < 2; ++vv) {
                const int vt = 2 * half + vv;
#pragma unroll
                for (int k2 = 0; k2 < 2; ++k2) {
                    const bf16x8 vf = *(const LAS bf16x8*)(lds + A128(RC_SVT, vt, k2));
                    const bf16x8 pf = *(const LAS bf16x8*)(lds + A128(RC_SP, it, k2));
                    accO[vv] = MFMA16(vf, pf, accO[vv]);
                }
                u32x2 w; w.x = pk2(accO[vv][0], accO[vv][1]); w.y = pk2(accO[vv][2], accO[vv][3]);
                *(u32x2*)(O + (size_t)(row0 + icol) * 2048 + h * 512 + vs * 64 + 16 * vt + 4 * fq) = w;
            }
            bf16x8 vfr[4][2];
#pragma unroll
            for (int vt = 0; vt < 4; ++vt) { vfr[vt][0] = *(const LAS bf16x8*)(lds + A128(RC_SVT, vt, 0)); vfr[vt][1] = *(const LAS bf16x8*)(lds + A128(RC_SVT, vt, 1)); }
#pragma unroll
            for (int di = 0; di < 2; ++di) {
                const int dt = 2 * wid + di;
                bf16x8 kt[2];
#pragma unroll
                for (int k2 = 0; k2 < 2; ++k2) kt[k2] = *(const LAS bf16x8*)(lds + A128(RC_SKT, dt, k2));
#pragma unroll
                for (int vt = 0; vt < 4; ++vt) {
                    f32x4 sacc = accS[di][vt] * cdec;
                    sacc = MFMA16(kt[0], vfr[vt][0], sacc); sacc = MFMA16(kt[1], vfr[vt][1], sacc);
                    accS[di][vt] = sacc;
                    const int v_ = 16 * vt + fr;
                    u32x2 w; w.x = pk2(sacc[0], sacc[1]); w.y = pk2(sacc[2], sacc[3]);
                    *(LAS u32x2*)(lds + RC_SS + v_ * 512 + (((2 * dt + (fq >> 1)) ^ (v_ & 15)) << 4) + (fq & 1) * 8) = w;
                }
            }
            LDS_BARRIER();
        }
    }
}
#undef A512
#undef A128
#undef RC_ISSUE
#undef RC_DMA_QK
#undef RC_ROW0
DI void ret_readout_phase(const Ctx& a) {
    const int tid_ = tid_opaque(); const int lane = tid_ & 63, gw = blockIdx.x * NWAVES + (tid_ >> 6), NGW = gridDim.x * NWAVES;
    const bf16_t* Of = (const bf16_t*)(a.ws + OFF_ACT); const bf16_t* Ob = Of + (size_t)MT * 2048;
    bf16_t* G = (bf16_t*)(a.ws + OFF_RG); const float* gn = a.rgn;
#define RO_OFF(it_) ((size_t)((it_) >> 2) * 2048 + ((it_) & 3) * 512 + 8 * lane)
    const f32x4 gA = *(const f32x4*)(gn + (gw & 3) * 512 + 8 * lane), gB = *(const f32x4*)(gn + (gw & 3) * 512 + 8 * lane + 4);
    u32x4 f1 = {0u, 0u, 0u, 0u}, b1 = f1, g1 = f1, f2 = f1, b2 = f1, g2 = f1, f3 = f1, b3 = f1, g3 = f1;
    if (gw < MT * 4) { const size_t o_ = RO_OFF(gw); f1 = *(const u32x4*)(Of + o_); b1 = *(const u32x4*)(Ob + o_); g1 = *(const u32x4*)(G + o_); }
    if (gw + NGW < MT * 4) { const size_t o_ = RO_OFF(gw + NGW); f2 = *(const u32x4*)(Of + o_); b2 = *(const u32x4*)(Ob + o_); g2 = *(const u32x4*)(G + o_); }
    if (gw + 2 * NGW < MT * 4) { const size_t o_ = RO_OFF(gw + 2 * NGW); f3 = *(const u32x4*)(Of + o_); b3 = *(const u32x4*)(Ob + o_); g3 = *(const u32x4*)(G + o_); }
    for (int it = gw; it < MT * 4; it += NGW) {
        const int h = it & 3; const size_t off = RO_OFF(it);
        const u32x4 vf = f1, vb = b1, gv = g1; f1 = f2; b1 = b2; g1 = g2; f2 = f3; b2 = b3; g2 = g3;
        if (it + 3 * NGW < MT * 4) { const size_t o_ = RO_OFF(it + 3 * NGW); f3 = *(const u32x4*)(Of + o_); b3 = *(const u32x4*)(Ob + o_); g3 = *(const u32x4*)(G + o_); }
        float o[8];
        o[0] = bflo(vf.x) + bflo(vb.x); o[1] = bfhi(vf.x) + bfhi(vb.x); o[2] = bflo(vf.y) + bflo(vb.y); o[3] = bfhi(vf.y) + bfhi(vb.y);
        o[4] = bflo(vf.z) + bflo(vb.z); o[5] = bfhi(vf.z) + bfhi(vb.z); o[6] = bflo(vf.w) + bflo(vb.w); o[7] = bfhi(vf.w) + bfhi(vb.w);
        float s = 0.f, s2 = 0.f;
#pragma unroll
        for (int e = 0; e < 8; ++e) { s += o[e]; s2 += o[e] * o[e]; }
        s = row16_sum(s); s2 = row16_sum(s2);
#pragma unroll
        for (int sh_ = 16; sh_ < 64; sh_ <<= 1) { const float a_ = shx(s, sh_, lane), b_ = shx(s2, sh_, lane); s += a_; s2 += b_; }
        const float mu = s * (1.f / 512.f);
        float var = s2 * (1.f / 512.f) - mu * mu; var = var < 0.f ? 0.f : var;
#pragma unroll
        for (int e = 0; e < 8; ++e) o[e] -= mu;
        const float rstd = 1.f / sqrtf(var + 1e-6f);
        u32x4 w;
        w.x = pk2(o[0] * rstd * gA[0] * bflo(gv.x), o[1] * rstd * gA[1] * bfhi(gv.x)); w.y = pk2(o[2] * rstd * gA[2] * bflo(gv.y), o[3] * rstd * gA[3] * bfhi(gv.y));
        w.z = pk2(o[4] * rstd * gB[0] * bflo(gv.z), o[5] * rstd * gB[1] * bfhi(gv.z)); w.w = pk2(o[6] * rstd * gB[2] * bflo(gv.w), o[7] * rstd * gB[3] * bfhi(gv.w));
        *(u32x4*)(G + off) = w;
    }
}

#undef RO_OFF
constexpr int AT_K = 0, AT_V = 24576, AT_BIAS = 49152;
template <bool SWA>
DI void attn_phase(const Ctx& a, LAS unsigned char* lds) {
    const bf16_t* QK = (const bf16_t*)(a.ws + OFF_AQK); const bf16_t* VT = (const bf16_t*)(a.ws + OFF_AVT); bf16_t* O = (bf16_t*)(a.ws + OFF_AO);
    const float* aux = SWA ? a.aux_swa : a.aux_nat;
    const int tid = tid_opaque(); const int lane = tid & 63, fr = lane & 15, fq = lane >> 4, w = tid >> 6;
    constexpr int LDQ = SWA ? 1280 : 2048, HD = SWA ? 256 : 1024, NLAT = 2048, NCTX = 128;
    const int G_ = gridDim.x, vb_ = (G_ % 8 == 0) ? (int)(blockIdx.x % 8) * (G_ / 8) + (int)(blockIdx.x / 8) : (int)blockIdx.x;
    for (int item = vb_; item < NLAT + NCTX; item += G_) {
        int b, kvh, hq, qbase, nloc, loc0 = 0;
        int r = 0, cbk = 0, r0 = 0, cs = 0, rlo = 0, tq0 = 0;
        const bool lat = item < NLAT;
        if (lat) {
            if (!SWA) { const int rp = item & 31; hq = (item >> 5) & 15; b = item >> 9; kvh = hq; r = 2 * rp + (w >> 2); cbk = w & 3; qbase = b * 4096 + r * 64 + 16 * cbk;
                r0 = r - 4 < 0 ? 0 : (r - 4 > 56 ? 56 : r - 4); cs = 16 * cbk - 8 < 0 ? 0 : (16 * cbk - 8 > 32 ? 32 : 16 * cbk - 8);
                rlo = 2 * rp - 4 < 0 ? 0 : (2 * rp - 4 > 56 ? 56 : 2 * rp - 4); const int rh = 2 * rp - 3 < 0 ? 0 : (2 * rp - 3 > 56 ? 56 : 2 * rp - 3);
                nloc = rh + 8 - rlo; loc0 = b * 4096 + rlo * 64; }
            else { const int tb = item & 127; kvh = (item >> 7) & 3; b = item >> 9; hq = kvh * 4 + (w >> 1); tq0 = 32 * tb + 16 * (w & 1); qbase = b * 4096 + tq0;
                int ts = (32 * tb - 128) & ~63; if (ts < 0) ts = 0;
                int te = (32 * tb + 159) >> 6; if (te > 63) te = 63;
                nloc = te - (ts >> 6) + 1; loc0 = b * 4096 + ts; rlo = ts; }
        } else {
            const int i2 = item - NLAT;
            if (!SWA) { const int hf = i2 & 1; hq = (i2 >> 1) & 15; b = i2 >> 5; kvh = hq; qbase = ML + b * 256 + 128 * hf + 16 * w; }
            else { const int q8 = i2 & 7; kvh = (i2 >> 3) & 3; b = i2 >> 5; hq = kvh * 4 + (w >> 1); qbase = ML + b * 256 + 32 * q8 + 16 * (w & 1); }
            nloc = 0;
        }
        const int koff = 1024 + kvh * 64, ntile = nloc + 4;
        int nb_off[8]; float nb_mask[8];
        if (!SWA) {
#pragma unroll
            for (int e = 0; e < 8; ++e) { const int col = cs + 16 * (e >> 2) + 4 * fq + (e & 3), ci = 16 * cbk + fr; const int c0 = ci - 8 < 0 ? 0 : (ci - 8 > 48 ? 48 : ci - 8);
                int bi = col - ci + 15; bi = bi < 0 ? 0 : (bi > 30 ? 30 : bi); nb_off[e] = AT_BIAS + 4 * bi; nb_mask[e] = ((col >= c0) && (col <= c0 + 15)) ? 0.f : -1e30f; }
        }
        bf16x8 qf[2];
#pragma unroll
        for (int ks = 0; ks < 2; ++ks) qf[ks] = *(const bf16x8*)(QK + (size_t)(qbase + fr) * LDQ + hq * 64 + 32 * ks + 8 * fq);
        float m_run = SWA ? aux[hq] : -1e30f, l_run = (SWA && fq == 0) ? 1.f : 0.f;
        f32x4 o[4];
#pragma unroll
        for (int dt = 0; dt < 4; ++dt) o[dt] = (f32x4){0.f, 0.f, 0.f, 0.f};
        const int srow = tid >> 3, sch = (tid & 7) ^ ((srow >> 1) & 7);
#define AT_TBASE(ti_) ((ti_) >= 4 ? loc0 + 64 * ((ti_) - 4) : ML + b * 256 + 64 * (ti_))
#define AT_DMA(ti_, bf_) do { const int kb_ = AT_TBASE(ti_); \
            __builtin_amdgcn_global_load_lds((const unsigned*)(QK + (size_t)(kb_ + srow) * LDQ + koff + sch * 8), (LAS unsigned*)(lds + AT_K + (bf_) * 8192 + w * 1024), 16, 0, 0); \
            __builtin_amdgcn_global_load_lds((const unsigned*)(VT + ((size_t)(kb_ >> 6) * HD + kvh * 64 + srow) * 64 + sch * 8), (LAS unsigned*)(lds + AT_V + (bf_) * 8192 + w * 1024), 16, 0, 0); } while (0)
        LDS_BARRIER();
        float bias_v = 0.f;
        if (!SWA) { if (tid < 15 * 31) bias_v = aux[hq * 465 + tid]; }
        AT_DMA(0, 0); AT_DMA(1, 1);
        if (!SWA) { if (tid < 15 * 31) ((LAS float*)(lds + AT_BIAS))[tid] = bias_v; }
        asm volatile("" :: "v"(qf[0]), "v"(qf[1]), "v"(m_run));
        asm volatile("s_waitcnt vmcnt(2)" ::: "memory");
        LDS_BARRIER();
        int buf = 0;
        for (int ti = 0; ti < ntile; ++ti) {
            const bool local = ti >= 4; const int tl = ti - 4;
            int nck = 2, k0off = 0, brow = 0;
            float bias[8];
            if (local) {
                if (!SWA) { const int gr = rlo + tl; nck = (gr >= r0 && gr <= r0 + 7) ? 1 : 0; k0off = cs; brow = gr - r + 7; brow = brow < 0 ? 0 : (brow > 14 ? 14 : brow);
#pragma unroll
                    for (int e = 0; e < 8; ++e) bias[e] = *(const LAS float*)(lds + nb_off[e] + brow * 124) + nb_mask[e]; }
            }
            { const int b2 = buf + 2 >= 3 ? buf - 1 : buf + 2; if (ti + 2 < ntile) AT_DMA(ti + 2, b2); }
            if (nck == 2) {
                const int tkey0 = rlo + 64 * tl;
                f32x4 sc[4];
#pragma unroll
                for (int jt = 0; jt < 4; ++jt) {
                    const int row = 16 * jt + fr; const int sw = (row >> 1) & 7;
                    const bf16x8 k0 = *(const LAS bf16x8*)(lds + AT_K + buf * 8192 + row * 128 + ((fq ^ sw) << 4));
                    const bf16x8 k1 = *(const LAS bf16x8*)(lds + AT_K + buf * 8192 + row * 128 + (((4 + fq) ^ sw) << 4));
                    f32x4 acc = (f32x4){0.f, 0.f, 0.f, 0.f}; acc = MFMA16(k0, qf[0], acc); acc = MFMA16(k1, qf[1], acc); sc[jt] = acc;
                }
                float sv[16]; bool ok[16];
#pragma unroll
                for (int jt = 0; jt < 4; ++jt)
#pragma unroll
                    for (int rr = 0; rr < 4; ++rr) {
                        bool valid = true;
                        if (SWA && local) { const int dd = tkey0 + 16 * jt + 4 * fq + rr - (tq0 + fr); valid = (dd <= 128) && (dd >= -128); }
                        sv[jt * 4 + rr] = valid ? sc[jt][rr] : -1e30f; ok[jt * 4 + rr] = valid;
                    }
                float cmax = sv[0];
#pragma unroll
                for (int e = 1; e < 16; ++e) cmax = fmaxf(cmax, sv[e]);
                cmax = fmaxf(cmax, shx(cmax, 16, lane)); cmax = fmaxf(cmax, shx(cmax, 32, lane));
                const float m_new = fmaxf(m_run, cmax);
                const float alpha = __builtin_amdgcn_exp2f((m_run - m_new) * LOG2E);
                float p[16], psum = 0.f;
#pragma unroll
                for (int e = 0; e < 16; ++e) { p[e] = ok[e] ? __builtin_amdgcn_exp2f((sv[e] - m_new) * LOG2E) : 0.f; psum += p[e]; }
                l_run = l_run * alpha + psum; m_run = m_new;
                u32x4 pw0, pw1; pw0.x = pk2(p[0], p[1]); pw0.y = pk2(p[2], p[3]); pw0.z = pk2(p[4], p[5]); pw0.w = pk2(p[6], p[7]);
                pw1.x = pk2(p[8], p[9]); pw1.y = pk2(p[10], p[11]); pw1.z = pk2(p[12], p[13]); pw1.w = pk2(p[14], p[15]);
                const bf16x8 pf0 = __builtin_bit_cast(bf16x8, pw0), pf1 = __builtin_bit_cast(bf16x8, pw1);
                if (__builtin_amdgcn_ballot_w64(alpha != 1.f) != 0ull) {
#pragma unroll
                    for (int dt = 0; dt < 4; ++dt) o[dt] = o[dt] * alpha;
                }
                const int kc = (fq >> 1), kb8 = (fq & 1) * 8;
#pragma unroll
                for (int dt = 0; dt < 4; ++dt) {
                    const int d = 16 * dt + fr, sw = (d >> 1) & 7; const int vb = AT_V + buf * 8192 + d * 128 + kb8;
                    const s16x4 v0 = *(const LAS s16x4*)(lds + vb + ((kc ^ sw) << 4)), v1 = *(const LAS s16x4*)(lds + vb + (((kc + 2) ^ sw) << 4));
                    const s16x4 v2 = *(const LAS s16x4*)(lds + vb + (((kc + 4) ^ sw) << 4)), v3 = *(const LAS s16x4*)(lds + vb + (((kc + 6) ^ sw) << 4));
                    o[dt] = MFMA16(__builtin_shufflevector(v0, v1, 0, 1, 2, 3, 4, 5, 6, 7), pf0, o[dt]);
                    o[dt] = MFMA16(__builtin_shufflevector(v2, v3, 0, 1, 2, 3, 4, 5, 6, 7), pf1, o[dt]);
                }
            } else
            for (int ck = 0; ck < nck; ++ck) {
                const int ko = k0off + 32 * ck;
                int tkey0 = 0;
                if (SWA && local) { tkey0 = rlo + 64 * tl + ko; if (tkey0 + 31 < tq0 - 128 || tkey0 > tq0 + 15 + 128) continue; }
                f32x4 sc[2];
#pragma unroll
                for (int jt = 0; jt < 2; ++jt) {
                    const int row = ko + 16 * jt + fr; const int sw = (row >> 1) & 7;
                    const bf16x8 k0 = *(const LAS bf16x8*)(lds + AT_K + buf * 8192 + row * 128 + ((fq ^ sw) << 4));
                    const bf16x8 k1 = *(const LAS bf16x8*)(lds + AT_K + buf * 8192 + row * 128 + (((4 + fq) ^ sw) << 4));
                    f32x4 acc = (f32x4){0.f, 0.f, 0.f, 0.f}; acc = MFMA16(k0, qf[0], acc); acc = MFMA16(k1, qf[1], acc); sc[jt] = acc;
                }
                float sv[8]; bool ok[8];
#pragma unroll
                for (int jt = 0; jt < 2; ++jt)
#pragma unroll
                    for (int rr = 0; rr < 4; ++rr) {
                        const int jj = 16 * jt + 4 * fq + rr; float x = sc[jt][rr]; bool valid = true;
                        if (local) {
                            if (!SWA) { x += bias[jt * 4 + rr]; }
                            else { const int dd = tkey0 + jj - (tq0 + fr); valid = (dd <= 128) && (dd >= -128); }
                        }
                        sv[jt * 4 + rr] = valid ? x : -1e30f; ok[jt * 4 + rr] = valid;
                    }
                float cmax = sv[0];
#pragma unroll
                for (int e = 1; e < 8; ++e) cmax = fmaxf(cmax, sv[e]);
                cmax = fmaxf(cmax, shx(cmax, 16, lane)); cmax = fmaxf(cmax, shx(cmax, 32, lane));
                const float m_new = fmaxf(m_run, cmax);
                const float alpha = __builtin_amdgcn_exp2f((m_run - m_new) * LOG2E);
                float p[8], psum = 0.f;
#pragma unroll
                for (int e = 0; e < 8; ++e) { p[e] = ok[e] ? __builtin_amdgcn_exp2f((sv[e] - m_new) * LOG2E) : 0.f; psum += p[e]; }
                l_run = l_run * alpha + psum; m_run = m_new;
                u32x4 pw; pw.x = pk2(p[0], p[1]); pw.y = pk2(p[2], p[3]); pw.z = pk2(p[4], p[5]); pw.w = pk2(p[6], p[7]);
                const bf16x8 pf = __builtin_bit_cast(bf16x8, pw);
                if (__builtin_amdgcn_ballot_w64(alpha != 1.f) != 0ull) {
#pragma unroll
                    for (int dt = 0; dt < 4; ++dt) o[dt] = o[dt] * alpha;
                }
                const int kc = (ko >> 3) + (fq >> 1), kb8 = (fq & 1) * 8;
#pragma unroll
                for (int dt = 0; dt < 4; ++dt) {
                    const int d = 16 * dt + fr, sw = (d >> 1) & 7;
                    const s16x4 v0 = *(const LAS s16x4*)(lds + AT_V + buf * 8192 + d * 128 + ((kc ^ sw) << 4) + kb8);
                    const s16x4 v1 = *(const LAS s16x4*)(lds + AT_V + buf * 8192 + d * 128 + (((kc + 2) ^ sw) << 4) + kb8);
                    const bf16x8 vfr = __builtin_shufflevector(v0, v1, 0, 1, 2, 3, 4, 5, 6, 7);
                    o[dt] = MFMA16(vfr, pf, o[dt]);
                }
            }
            if (ti + 2 < ntile) asm volatile("s_waitcnt vmcnt(2)" ::: "memory"); else asm volatile("s_waitcnt vmcnt(0)" ::: "memory");
            LDS_BARRIER();
            buf = buf == 2 ? 0 : buf + 1;
        }
        float l_tot = l_run; l_tot += shx(l_tot, 16, lane); l_tot += shx(l_tot, 32, lane);
        const float inv = 1.f / l_tot;
#pragma unroll
        for (int dt = 0; dt < 4; ++dt) { u32x2 wv; wv.x = pk2(o[dt][0] * inv, o[dt][1] * inv); wv.y = pk2(o[dt][2] * inv, o[dt][3] * inv);
            *(u32x2*)(O + (size_t)(qbase + fr) * 1024 + hq * 64 + 16 * dt + 4 * fq) = wv; }
    }
#undef AT_DMA
#undef AT_TBASE
}

#define XB_TMO      128
#define XB_XCNT(j)  (256  + 64 * (j))
#define XB_XSUB(j)  (1280 + 64 * (j))
#define XB_XGEN(j)  (2304 + 64 * (j))
#define XB_TOP      3328
#define XB_TOPGEN   3392
#define XCD_BAR_WORDS 3456
#define XB_SPIN_CAP (1u << 18)

__device__ __forceinline__ unsigned xb_ld(unsigned* p)              { return __hip_atomic_load(p, __ATOMIC_RELAXED, __HIP_MEMORY_SCOPE_AGENT); }
__device__ __forceinline__ unsigned xb_add(unsigned* p, unsigned v) { return __hip_atomic_fetch_add(p, v, __ATOMIC_RELAXED, __HIP_MEMORY_SCOPE_AGENT); }
__device__ __forceinline__ unsigned xb_xcc_id() { return (unsigned)__builtin_amdgcn_s_getreg((3 << 11) | 20) & 0xFu; }
#define XB_SPIN(cond, bar) do { unsigned _sp = 0; while (cond) { __builtin_amdgcn_s_sleep(1); \
    if ((++_sp & 255u) == 0u) { if (xb_ld(&(bar)[XB_TMO])) break; if (_sp > XB_SPIN_CAP) { atomicAdd(&(bar)[XB_TMO], 1u); break; } } } } while (0)

struct XcdBarrier {
    unsigned* bar; unsigned x;
    volatile LAS unsigned* st;
};

__device__ __forceinline__ XcdBarrier xcd_barrier_post(unsigned* bar, volatile LAS unsigned* st) {
    XcdBarrier b; b.bar = bar; b.x = xb_xcc_id(); b.st = st;
    if (threadIdx.x == 0) (void)xb_add(&bar[XB_XCNT(b.x)], 1u);
    return b;
}
__device__ __forceinline__ void xcd_barrier_complete(unsigned* bar, unsigned x, unsigned& nloc, unsigned& nx) {
    const unsigned G = gridDim.x * gridDim.y * gridDim.z;
    unsigned sum, cnt, mine, sp = 0u;
    for (;;) {
        sum = 0u; cnt = 0u; mine = 0u;
#pragma unroll
        for (unsigned j = 0; j < 16; ++j) { const unsigned c = xb_ld(&bar[XB_XCNT(j)]); sum += c; cnt += (c > 0u) ? 1u : 0u; mine = (j == x) ? c : mine; }
        if (sum == G) break;
        __builtin_amdgcn_s_sleep(1);
        if ((++sp & 255u) == 0u) { if (xb_ld(&bar[XB_TMO])) break; if (sp > XB_SPIN_CAP) { atomicAdd(&bar[XB_TMO], 1u); break; } }
    }
    nloc = mine > 0u ? mine : 1u; nx = cnt > 0u ? cnt : 1u;
}

__device__ __forceinline__ void xcd_barrier(const XcdBarrier& b) {
    asm volatile("s_waitcnt vmcnt(0)" ::: "memory");
    __syncthreads();
    if (threadIdx.x == 0) {
        unsigned* bar = b.bar;
        __builtin_amdgcn_s_waitcnt(0);
        unsigned nloc = b.st[0], nx = b.st[1];
        if (nloc == 0u) { xcd_barrier_complete(bar, b.x, nloc, nx); b.st[0] = nloc; b.st[1] = nx; }
        const unsigned old = xb_add(&bar[XB_XSUB(b.x)], 1u);
        const unsigned gen = old / nloc;
        if (old + 1u == (gen + 1u) * nloc) {
            __builtin_amdgcn_fence(__ATOMIC_RELEASE, "agent");
            asm volatile("s_waitcnt vmcnt(0)" ::: "memory");
            const unsigned og = xb_add(&bar[XB_TOP], 1u);
            const unsigned tg = og / nx;
            if (og + 1u == (tg + 1u) * nx) xb_add(&bar[XB_TOPGEN], 1u);
            else XB_SPIN(xb_ld(&bar[XB_TOPGEN]) == tg, bar);
            __builtin_amdgcn_fence(__ATOMIC_ACQUIRE, "agent");
            xb_add(&bar[XB_XGEN(b.x)], 1u);
            asm volatile("s_waitcnt vmcnt(0)" ::: "memory");
        } else {
            XB_SPIN(xb_ld(&bar[XB_XGEN(b.x)]) == gen, bar);
            __builtin_amdgcn_fence(__ATOMIC_ACQUIRE, "agent");
            asm volatile("s_waitcnt vmcnt(0)" ::: "memory");
        }
    }
    __syncthreads();
}

constexpr int N_PHASES = 46;
__host__ __device__ inline bool phase_empty(int ph) {
    if (ph == 0 || ph == 45) return false;
    const int l = (ph - 1) / 11, k = (ph - 1) % 11;
    if (k == 6 && l != 0) return true;
    if (k == 5 && l == 2) return true;
    return false;
}

__global__ void __launch_bounds__(NTHREADS) mega(Args a) {
    extern __shared__ __attribute__((aligned(16))) unsigned char lds_raw[];
    LAS unsigned char* lds = (LAS unsigned char*)lds_raw;
#if !MK_MULTI
    volatile LAS unsigned* bst = (volatile LAS unsigned*)(lds + LDS_PHASE_BYTES);
    if (threadIdx.x < 2) bst[threadIdx.x] = 0u;
    __syncthreads();
    const XcdBarrier xbar = xcd_barrier_post((unsigned*)(a.ws + OFF_BAR), bst);
#endif
    for (int ph = a.ph_lo; ph < a.ph_hi; ++ph) {
        if (phase_empty(ph)) continue;
        size_t zoff_ = 0; asm volatile("" : "+s"(zoff_));
        unsigned char* ws = a.ws + zoff_;
        int G = gridDim.x, bid = blockIdx.x; asm volatile("" : "+s"(G), "+s"(bid));
        const Ctx al{ws, a.out, a.in[I_NORMG], a.in[I_FNG], a.in[I_RGN], a.in[I_NRPB], a.in[I_SSINK], a.in[I_PSC], a.in[I_X], a.in[I_CTX]};
        const float* mod = (const float*)(ws + OFF_MOD);
        int dupbit = 0;
        if (ph == 0) dupbit = 1; else if (ph != 45) { const int l_ = (ph - 1) / 11, k_ = (ph - 1) % 11;
            if (k_ == 0 || k_ == 3 || k_ == 8) dupbit = 2; else if (k_ == 1 || k_ == 9) dupbit = 4; else if (k_ == 4) dupbit = 8 << l_; else if (k_ == 5) dupbit = 128 << l_; else if (k_ == 6) dupbit = 2048; else if (k_ == 2 || k_ == 7 || k_ == 10) dupbit = 4096; }
        const int nrep = (MK_DUP & dupbit) ? 2 : 1;
        for (int rep = 0; rep < nrep; ++rep) {
        if (ph == 0) { if (MK_MASK & 1) prologue(a, lds); }
        else if (ph == 45) { if (MK_MASK & 2) final_phase(al); }
        else {
            const int l = (ph - 1) / 11, k = (ph - 1) % 11;
            if (k == 0 || k == 3 || k == 8) { if (MK_MASK & 2) { const int nslm = l == 0 ? 8 : (l == 2 ? 1 : 4);
                    norm_phase(al, l, k == 0 ? 0 : (k == 3 ? 1 : 2), ph == 1, (const float*)(ws + (k == 8 ? OFF_ACT : OFF_MIX)), k == 8 ? nslm : 11, (l == 3 && k == 8) ? ML : MT); } }
            else if (k == 1 || k == 9) {
                const int s = k == 1 ? 0 : 1;
                pg8::Gemm g{(const bf16_t*)(ws + OFF_XN), (const bf16_t*)(ws + OFF_WFI) + (size_t)(l * 2 + s) * 5632 * 1024, 1024, 1024, 1024, (l == 3 && k == 9) ? 64 : MT / 256, 22, 0, nullptr, nullptr};
                pg8::StaticOrder S; S.init(g.nM, g.nN, G, bid, g.K);
                EpiSwiglu E{(bf16_t*)(ws + OFF_ACT)};
                if (MK_MASK & 4) pg8::gemm_phase(lds, g, S, E);
            } else if (k == 2 || k == 10 || k == 7) {
                const bf16_t* gA; const bf16_t* gB; int lda, ldb, K_, apo = 0; const float* csc = nullptr; const float* gate; float w_;
                if (k != 7) {
                    const int s = k == 2 ? 0 : 1;
                    gA = (const bf16_t*)(ws + OFF_ACT); gB = (const bf16_t*)(ws + OFF_WFO) + (size_t)(l * 2 + s) * 1024 * 2816; lda = 2816; ldb = 2816; K_ = 2816;
                    gate = mod + (size_t)l * 5 * MODW + ((k == 2 ? 0 : 2) * 3 + 2) * 1024; w_ = 0.5f;
                } else {
                    gate = mod + (size_t)l * 5 * MODW + (1 * 3 + 2) * 1024; w_ = 1.f;
                    if (l == 0) { gA = (const bf16_t*)(ws + OFF_RG); gB = (const bf16_t*)(ws + OFF_WRO); lda = 2048; ldb = 2048; K_ = 2048; }
                    else if (l == 1) { gA = (const bf16_t*)(ws + OFF_AO); gB = (const bf16_t*)(ws + OFF_WNO); lda = 1024; ldb = 1024; K_ = 1024; }
                    else if (l == 2) { gA = (const bf16_t*)(ws + OFF_PL); gB = (const bf16_t*)(ws + OFF_WPL); lda = 1024; ldb = 256; K_ = 256; apo = 256; csc = al.psc; }
                    else { gA = (const bf16_t*)(ws + OFF_AO); gB = (const bf16_t*)(ws + OFF_WSO); lda = 1024; ldb = 1024; K_ = 1024; }
                }
                const pg8::Gemm g{gA, gB, lda, ldb, K_, 64, 4, apo, nullptr, nullptr};
                const EpiResid E{(float*)(ws + OFF_H), (l == 0 && k == 2) ? al.x : (const float*)(ws + OFF_H), gate, csc, (float*)(ws + (k == 7 ? OFF_ACT : OFF_MIX)), (nrep == 2 && rep == 0) ? 0.f : w_, 0.f};
                pg8::StaticOrder S; S.init(64, 4, G, bid, K_, (l == 3 && k >= 7) ? 0 : 4);
                if (MK_MASK & 8) pg8::gemm_phase(lds, g, S, E);
            } else if (k == 4) {
                const bf16_t* XN = (const bf16_t*)(ws + OFF_XN);
                if (l == 0) {
                    pg8::Gemm g{XN, (const bf16_t*)(ws + OFF_WRI), 1024, 1024, 1024, MT / 256, 16, 0, (const bf16_t*)(ws + OFF_WRI) + (size_t)3072 * 1024, XN};
                    pg8::StaticOrder S; S.init(MT / 256, 16, G, bid, 1024, 0, 12, MT / 256);
                    EpiDual<EpiRetNat, EpiRetSwp> E{EpiRetNat{(bf16_t*)(ws + OFF_RG), (bf16_t*)(ws + OFF_RQ), (bf16_t*)(ws + OFF_RK), (const f32x2*)(ws + OFF_CS)},
                                                    EpiRetSwp{(bf16_t*)(ws + OFF_RKTF), (bf16_t*)(ws + OFF_RKTB), (bf16_t*)(ws + OFF_RVT), (const f32x2*)(ws + OFF_CST), (const float*)(ws + OFF_DEC)}};
                    if (MK_MASK & 16) pg8::gemm_phase(lds, g, S, E);
                } else if (l == 2) {
                    if (MK_MASK & 2) pool_phase(al);
                } else if (l == 1) {
                    pg8::Gemm g{XN, (const bf16_t*)(ws + OFF_WNQ), 1024, 1024, 1024, MT / 256, 8, 0, (const bf16_t*)(ws + OFF_WNQ) + (size_t)2048 * 1024, XN};
                    pg8::StaticOrder S; S.init(MT / 256, 8, G, bid, 1024, 0, 4, MT / 256);
                    EpiDual<EpiBf16, EpiBf16> E{EpiBf16{(bf16_t*)(ws + OFF_AQK), 2048, 4, 0.125f, 0, 0}, EpiBf16{(bf16_t*)(ws + OFF_AVT), MT, 0, 1.f, 1024, 0}};
                    if (MK_MASK & 64) pg8::gemm_phase(lds, g, S, E);
                } else {
                    pg8::Gemm g{XN, (const bf16_t*)(ws + OFF_WSQ), 1024, 1024, 1024, MT / 256, 5, 0, (const bf16_t*)(ws + OFF_WSQ) + (size_t)1280 * 1024, XN};
                    pg8::StaticOrder S; S.init(MT / 256, 5, G, bid, 1024, 0, 1, MT / 256);
                    EpiDual<EpiSwaNat, EpiBf16> E{EpiSwaNat{(bf16_t*)(ws + OFF_AQK), (const f32x2*)(ws + OFF_CS2)}, EpiBf16{(bf16_t*)(ws + OFF_AVT), MT, 0, 1.f, 256, 0}};
                    if (MK_MASK & 128) pg8::gemm_phase(lds, g, S, E);
                }
            } else if (k == 5) {
                if (l == 0) { if (MK_MASK & 512) ret_chain_phase(al, lds); }
                else if (l == 1) { if (MK_MASK & 1024) attn_phase<false>(al, lds); }
                else if (l == 3) { if (MK_MASK & 2048) attn_phase<true>(al, lds); }
            } else if (k == 6) {
                if (MK_MASK & 2) ret_readout_phase(al);
            }
        }
        }
#if !MK_MULTI
        if (ph + 1 < a.ph_hi) { if (ph == 0) cg::this_grid().sync(); else xcd_barrier(xbar); }
#endif
    }
}

extern "C" void kernel_launch(void* const* d_in, const int* in_sizes, int n_in, void* d_out, int out_size, void* d_ws, size_t ws_size, hipStream_t stream) {
    static int grid = 0;
    if (grid == 0) {
        if (n_in != 23 || ws_size < WS_END) { fprintf(stderr, "kernel_launch: need 23 inputs and %zu bytes of workspace (got %d, %zu)\n", (size_t)WS_END, n_in, ws_size); grid = -1; return; }
        int dev = 0, cus = 0, per_cu = 0;
        hipGetDevice(&dev); hipDeviceGetAttribute(&cus, hipDeviceAttributeMultiprocessorCount, dev);
        if (hipFuncSetAttribute((const void*)mega, hipFuncAttributeMaxDynamicSharedMemorySize, LDS_BYTES) != hipSuccess) { fprintf(stderr, "kernel_launch: hipFuncSetAttribute failed\n"); grid = -1; return; }
        if (hipOccupancyMaxActiveBlocksPerMultiprocessor(&per_cu, (const void*)mega, NTHREADS, LDS_BYTES) != hipSuccess || per_cu < 1) { fprintf(stderr, "kernel_launch: occupancy query gives %d\n", per_cu); per_cu = 1; }
        (void)hipGetLastError();
        grid = cus * 1;
        if (grid > 256) grid = 256;
    }
    if (grid < 0) return;
    Args a{};
    for (int i = 0; i < 23; ++i) a.in[i] = (const float*)d_in[i];
    a.out = (float*)d_out; a.ws = (unsigned char*)d_ws;
#if MK_MULTI
    for (int ph = 0; ph < N_PHASES; ++ph) {
        if (phase_empty(ph)) continue;
        a.ph_lo = ph; a.ph_hi = ph + 1;
        hipLaunchKernelGGL(mega, dim3(grid), dim3(NTHREADS), LDS_BYTES, stream, a);
    }
#else
    a.ph_lo = 0; a.ph_hi = N_PHASES;
    if (hipMemsetAsync((char*)d_ws, 0, OFF_BAR + 16384, stream) != hipSuccess) { fprintf(stderr, "kernel_launch: memset of barrier words failed\n"); return; }
    void* args[] = {&a};
    hipError_t e = hipLaunchCooperativeKernel((const void*)mega, dim3(grid), dim3(NTHREADS), args, LDS_BYTES, stream);
    if (e != hipSuccess) fprintf(stderr, "cooperative launch failed: %s (grid %d)\n", hipGetErrorString(e), grid);
#endif
}
```
